# Optimizing an MI355X kernel written in HIP

```python
import jax, jax.numpy as jnp
from jax import lax
import numpy as np

D_MODEL = 1024
BATCH = 16
SEQ = 4096
DEPTH = 2
DEC_BATCH = 16
DEC_SEQ = 16
PAST_LEN = 1024

CHUNK = 64
MIX_WIDTH = D_MODEL
POOL_WINDOWS = (2, 4, 8, 16)
POOL_GROUP_DIM = D_MODEL // 16
POOL_WIDTH = len(POOL_WINDOWS) * POOL_GROUP_DIM
POOL_HIST = max(POOL_WINDOWS) - 1
CONV_WIDTH = 3 * D_MODEL // 8
CONV_K = 3
CONV_HIST = CONV_K - 1
GMLP_WIDTH = 3 * D_MODEL // 8
GMLP_HEADS = 6
GMLP_HEAD_DIM = GMLP_WIDTH // GMLP_HEADS
GMLP_CHUNK = 128
SPLIT_SIZES = (POOL_WIDTH, POOL_WIDTH,
               CONV_WIDTH, CONV_WIDTH, CONV_WIDTH, CONV_WIDTH,
               GMLP_WIDTH, GMLP_WIDTH, GMLP_WIDTH)
PROJ_WIDTH = sum(SPLIT_SIZES)
EPS = 1e-6

kernel_name = "hybrid_pool_conv_gmlp_stream_step"


def rmsnorm(x, g):
    x32 = x.astype(jnp.float32)
    y = x32 * lax.rsqrt(jnp.mean(x32 * x32, axis=-1, keepdims=True) + EPS)
    return (y * g.astype(jnp.float32)).astype(x.dtype)


def layernorm(x, g, b):
    x32 = x.astype(jnp.float32)
    mu = jnp.mean(x32, axis=-1, keepdims=True)
    var = jnp.mean(jnp.square(x32 - mu), axis=-1, keepdims=True)
    y = (x32 - mu) * lax.rsqrt(var + EPS)
    return (y * g.astype(jnp.float32) + b.astype(jnp.float32)).astype(x.dtype)


def pool_mix(p, hist, pos0, w_pool, pool_scale):
    L = p.shape[1]
    full = jnp.concatenate([hist, p], axis=1)
    cs = jnp.cumsum(full.astype(jnp.float32), axis=1)
    cs = jnp.pad(cs, ((0, 0), (1, 0), (0, 0)))
    pos = pos0 + jnp.arange(L, dtype=jnp.int32)
    outs = []
    for g, w in enumerate(POOL_WINDOWS):
        sl = slice(g * POOL_GROUP_DIM, (g + 1) * POOL_GROUP_DIM)
        wsum = cs[:, POOL_HIST + 1:, sl] - cs[:, POOL_HIST + 1 - w:POOL_HIST + 1 - w + L, sl]
        cnt = jnp.minimum(pos + 1, w).astype(jnp.float32)
        d = (wsum / cnt[None, :, None]).astype(p.dtype) - p[..., sl]
        outs.append(jnp.einsum('bld,de->ble', d, w_pool[g]))
    out = jnp.concatenate(outs, axis=-1) * pool_scale
    return out, full[:, -POOL_HIST:]


def conv_mix(q, hist, w_conv):
    L = q.shape[1]
    full = jnp.concatenate([hist, q], axis=1)
    out = sum(w_conv[k] * full[:, k:k + L] for k in range(CONV_K))
    return out, full[:, -CONV_HIST:]


def gmlp_mix(u, v, w_s, b_s):
    B, L, _ = v.shape
    n = min(L, GMLP_CHUNK)
    blk = jnp.arange(n) // CHUNK
    mask = blk[None, :] <= blk[:, None]
    w = jnp.where(mask[None], w_s[:, :n, :n], 0)
    vh = v.reshape(B, L // n, n, GMLP_HEADS, GMLP_HEAD_DIM)
    mixed = jnp.einsum('hts,bcshd->bcthd', w, vh) + b_s[:, :n].T[None, None, :, :, None]
    return u * mixed.reshape(B, L, GMLP_WIDTH)


def layer(x, c, pool_hist, conv_hist, pos0, norm_g, w_ada, b_ada, w_in, w_pool, pool_scale,
          w_conv, v_norm_g, v_norm_b, w_s, b_s, w_out):
    mod = jax.nn.silu(c) @ w_ada + b_ada
    shift, scale, gate = jnp.split(mod, 3, axis=-1)
    h = rmsnorm(x, norm_g) * (1 + scale[:, None]) + shift[:, None]
    z = h @ w_in
    p, z_pool, gb, gc, hx, z_conv, u, v, z_gmlp = jnp.split(
        z, list(np.cumsum(SPLIT_SIZES)[:-1]), axis=-1)
    y_pool, new_pool = pool_mix(p, pool_hist, pos0, w_pool, pool_scale)
    y_conv, new_conv = conv_mix(gc * hx, conv_hist, w_conv)
    vn = layernorm(v, v_norm_g, v_norm_b)
    y_gmlp = gmlp_mix(u, vn, w_s, b_s)
    y = jnp.concatenate([y_pool * jax.nn.silu(z_pool),
                         gb * y_conv * jax.nn.silu(z_conv),
                         y_gmlp * jax.nn.silu(z_gmlp)], axis=-1) @ w_out
    return x + gate[:, None] * y, new_pool, new_conv, vn


def setup_inputs(seed: int = 0) -> dict:
    key = jax.random.key(seed)
    ks = jax.random.split(key, 20)
    nrm = lambda k, s, sc: jax.random.normal(k, s, jnp.float32) * sc
    D = D_MODEL
    return {
        "x_prompt": nrm(ks[0], (BATCH, SEQ, D), 1.0),
        "x_sample": nrm(ks[1], (DEC_BATCH, DEC_SEQ, D), 1.0),
        "state_pool": nrm(ks[2], (DEPTH, DEC_BATCH, POOL_HIST, POOL_WIDTH), 1.0),
        "state_conv": nrm(ks[3], (DEPTH, DEC_BATCH, CONV_HIST, CONV_WIDTH), 1.0),
        "c_prompt": nrm(ks[4], (BATCH, D), 1.0),
        "c_sample": nrm(ks[5], (DEC_BATCH, D), 1.0),
        "norm_g": 1.0 + nrm(ks[6], (DEPTH, D), 0.05),
        "w_ada": nrm(ks[7], (DEPTH, D, 3 * D), 0.5 * D ** -0.5),
        "b_ada": nrm(ks[8], (DEPTH, 3 * D), 0.02),
        "w_in": nrm(ks[9], (DEPTH, D, PROJ_WIDTH), D ** -0.5),
        "w_pool": nrm(ks[10], (DEPTH, len(POOL_WINDOWS), POOL_GROUP_DIM, POOL_GROUP_DIM), POOL_GROUP_DIM ** -0.5),
        "pool_scale": 1.0 + nrm(ks[11], (DEPTH, POOL_WIDTH), 0.1),
        "w_conv": nrm(ks[12], (DEPTH, CONV_K, CONV_WIDTH), CONV_K ** -0.5),
        "v_norm_g": 1.0 + nrm(ks[13], (DEPTH, GMLP_WIDTH), 0.05),
        "v_norm_b": nrm(ks[14], (DEPTH, GMLP_WIDTH), 0.02),
        "w_s": nrm(ks[15], (DEPTH, GMLP_HEADS, GMLP_CHUNK, GMLP_CHUNK), GMLP_CHUNK ** -0.5),
        "b_s": 1.0 + nrm(ks[16], (DEPTH, GMLP_HEADS, GMLP_CHUNK), 0.1),
        "w_out": nrm(ks[17], (DEPTH, MIX_WIDTH, D), MIX_WIDTH ** -0.5),
        "final_norm_g": 1.0 + nrm(ks[18], (D,), 0.05),
    }


def reference(x_prompt, x_sample, state_pool, state_conv, c_prompt, c_sample, norm_g, w_ada, b_ada,
              w_in, w_pool, pool_scale, w_conv, v_norm_g, v_norm_b, w_s, b_s, w_out, final_norm_g):
    xp, xs = x_prompt, x_sample
    zero_pool = jnp.zeros((xp.shape[0], POOL_HIST, POOL_WIDTH), xp.dtype)
    zero_conv = jnp.zeros((xp.shape[0], CONV_HIST, CONV_WIDTH), xp.dtype)
    pool_p, conv_p, pool_s, conv_s, v_s = [], [], [], [], []
    for l in range(DEPTH):
        params = (norm_g[l], w_ada[l], b_ada[l], w_in[l], w_pool[l], pool_scale[l], w_conv[l],
                  v_norm_g[l], v_norm_b[l], w_s[l], b_s[l], w_out[l])
        xp, npool, nconv, _ = layer(xp, c_prompt, zero_pool, zero_conv, 0, *params)
        pool_p.append(npool)
        conv_p.append(nconv)
        xs, npool, nconv, vrows = layer(xs, c_sample, state_pool[l], state_conv[l], PAST_LEN, *params)
        pool_s.append(npool)
        conv_s.append(nconv)
        v_s.append(vrows)
    y_prompt = rmsnorm(xp, final_norm_g)
    y_sample = rmsnorm(xs, final_norm_g)
    return (y_prompt, y_sample, jnp.stack(pool_p), jnp.stack(conv_p), jnp.stack(pool_s),
            jnp.stack(conv_s), jnp.stack(v_s))
```

```cpp
#include <hip/hip_runtime.h>
#include <hip/hip_cooperative_groups.h>
#include <cstdio>
#include <cstdint>
#include <cstddef>
namespace cg = cooperative_groups;
namespace pg8 {
#define PG8_LAS __attribute__((address_space(3)))
typedef unsigned short bf16_t;
typedef short bf16x8 __attribute__((ext_vector_type(8)));
typedef float f32x4 __attribute__((ext_vector_type(4)));
typedef unsigned u32x4 __attribute__((ext_vector_type(4)));
constexpr int BM = 256, BK = 64, HALF = 128, HTB = HALF * BK * 2  , STAGE_BYTES = 8 * HTB, NXCD = 8, WGM = 8;

__host__ __device__ __forceinline__ int lds_byte(int r, int c) { const int st = (r >> 4) * 2 + (c >> 5), rr = r & 15, cc = c & 31, ob = rr * 64 + cc * 2; return st * 1024 + (ob ^ (((ob >> 9) & 1) << 5)); }
__host__ __device__ __forceinline__ void stage_rc(int b, int& R, int& C) { const int st = b / 1024, sb = b % 1024, swz = sb ^ (((sb >> 9) & 1) << 5); R = (st >> 1) * 16 + swz / 64; C = (st & 1) * 32 + (swz % 64) / 2; }
__host__ __device__ __forceinline__ int perm32(int rho) { const int n = rho >> 4, i = rho & 15; return 8 * (i >> 2) + 4 * n + (i & 3); }

struct Unit { int pm, pn; };
struct Gemm { const bf16_t* A; const bf16_t* Bt; int M, N, K; };

struct StaticOrder {
    int nM, nN, nwg, G, c;
    __host__ __device__ void init(int M, int N, int G_, int c_) { nM = M / BM; nN = N / BM; nwg = nM * nN; G = G_; c = c_; }
    __host__ __device__ bool next(int i, Unit& u) const {
        const long L = (long)i * G + c; if (L >= nwg) return false;
        int wgid = (int)L; { const int q = nwg / NXCD, r = nwg % NXCD, xcd = wgid % NXCD, off = wgid / NXCD; wgid = (xcd < r ? xcd * (q + 1) : r * (q + 1) + (xcd - r) * q) + off; }
        const int nig = WGM * nN, gid = wgid / nig, fm = gid * WGM, gsz = (nM - fm) < WGM ? (nM - fm) : WGM;
        u.pm = fm + ((wgid % nig) % gsz); u.pn = (wgid % nig) / gsz; return true;
    }
    __device__ __forceinline__ void a_ready(const Unit&) const {}
    __device__ __forceinline__ void done(const Unit&) const {}
};


__device__ __forceinline__ unsigned cvt_pk_bf16(float lo, float hi) { unsigned r; asm volatile("v_cvt_pk_bf16_f32 %0, %1, %2" : "=v"(r) : "v"(lo), "v"(hi)); return r; }

struct EpiZ {
    static constexpr bool PERM = true, AFTER_DRAIN = false;
    bf16_t* O; int ldc;
    __device__ __forceinline__ void operator()(const f32x4 (&acc)[2][2][4][2], const Unit& u, int wr, int wc, int fr, int fq) const {
        const int row0 = u.pm * BM + wr * 64 + fr, col0 = u.pn * BM + wc * 32 + 8 * fq;
#pragma unroll
        for (int ai = 0; ai < 2; ++ai)
#pragma unroll
            for (int m = 0; m < 4; ++m) { bf16_t* rowp = O + (size_t)(row0 + ai * HALF + m * 16) * ldc + col0;
#pragma unroll
                for (int bj = 0; bj < 2; ++bj) { const f32x4 v0 = acc[ai][bj][m][0], v1 = acc[ai][bj][m][1];
                    u32x4 w; w.x = cvt_pk_bf16(v0[0], v0[1]); w.y = cvt_pk_bf16(v0[2], v0[3]); w.z = cvt_pk_bf16(v1[0], v1[1]); w.w = cvt_pk_bf16(v1[2], v1[3]);
                    *(u32x4*)(rowp + bj * HALF) = w; } }
    }
};
struct EpiRes {
    static constexpr bool PERM = false, AFTER_DRAIN = false;
    const float* baseP; const float* baseS; float* out; const float* gate; int MP;
    __device__ __forceinline__ void operator()(const f32x4 (&acc)[2][2][4][2], const Unit& u, int wr, int wc, int fr, int fq) const {
        const int col0 = u.pn * BM + wc * 32 + 4 * fq;
#pragma unroll
        for (int ai = 0; ai < 2; ++ai)
#pragma unroll
            for (int m = 0; m < 4; ++m) {
                const int grow = u.pm * BM + ai * HALF + wr * 64 + m * 16 + fr;
                const int r = grow < MP ? (grow >> 12) : 16 + ((grow - MP) >> 4);
                const float* bp = grow < MP ? baseP + (size_t)grow * 1024 : baseS + (size_t)(grow - MP) * 1024;
                float* op = out + (size_t)grow * 1024; const float* gp = gate + (size_t)r * 3072;
#pragma unroll
                for (int bj = 0; bj < 2; ++bj)
#pragma unroll
                    for (int n = 0; n < 2; ++n) { const int c = col0 + bj * HALF + n * 16;
                        const f32x4 g = *(const f32x4*)(gp + c), b = *(const f32x4*)(bp + c);
                        *(f32x4*)(op + c) = b + g * acc[ai][bj][m][n]; }
                asm volatile("" ::: "memory"); }
    }
};

template <class Epi, class Sched, bool ALIGN_EPI = false, bool SP2 = false>
__device__ __forceinline__ void gemm_phase(PG8_LAS unsigned char* lds, const Gemm g, const Sched& S, const Epi& E) {
    int tid_ = threadIdx.x; asm volatile("" : "+v"(tid_));
    const int tid = tid_, wid = __builtin_amdgcn_readfirstlane(tid >> 6), lane = tid & 63, wr = wid >> 2, wc = wid & 3, fr = lane & 15, fq = lane >> 4;
    const int K = g.K, nt = K / BK;
    unsigned voffA[2], voffB[2];
#pragma unroll
    for (int i = 0; i < 2; ++i) { int R, C; stage_rc(tid * 16 + i * 8192, R, C); const int Rb = Epi::PERM ? ((R & ~31) + perm32(R & 31)) : R;
        voffA[i] = (unsigned)(R * K + C) * 2u; voffB[i] = (unsigned)(Rb * K + C) * 2u; }
    const size_t kstep = (size_t)(BK * 2);
    const size_t hstep = (size_t)HALF * K * 2;
    const size_t tstep = 2 * hstep;
    const unsigned ldsw = (unsigned)wid * 1024u;
    const int aoff = lds_byte(wr * 64 + fr, fq * 8), boff = lds_byte(wc * 32 + fr, fq * 8);
#define PG8_SA(b, h) (((b) * 2 + (h)) * HTB)
#define PG8_SB(b, h) ((4 + (b) * 2 + (h)) * HTB)
#define PG8_STAGE(bufoff, gbase, voff) do { _Pragma("unroll") for (int _i = 0; _i < 2; ++_i) \
        __builtin_amdgcn_global_load_lds((const unsigned*)((const char*)(gbase) + (voff)[_i]), (PG8_LAS unsigned*)(lds + (bufoff) + ldsw + _i * 8192), 16, 0, 0); } while (0)
#define PG8_LDA(dst, b, h) do { _Pragma("unroll") for (int m = 0; m < 4; ++m) _Pragma("unroll") for (int k = 0; k < 2; ++k) dst[m][k] = *(const PG8_LAS bf16x8*)(lds + PG8_SA(b, h) + aoff + m * 2048 + k * 1024); } while (0)
#define PG8_LDB(dst, b, h) do { _Pragma("unroll") for (int n = 0; n < 2; ++n) _Pragma("unroll") for (int k = 0; k < 2; ++k) dst[n][k] = *(const PG8_LAS bf16x8*)(lds + PG8_SB(b, h) + boff + n * 2048 + k * 1024); } while (0)
#define PG8_MMA(ai, bj, At, Bt) do { __builtin_amdgcn_s_setprio(1); _Pragma("unroll") for (int m = 0; m < 4; ++m) _Pragma("unroll") for (int n = 0; n < 2; ++n) _Pragma("unroll") for (int k = 0; k < 2; ++k) \
        acc[ai][bj][m][n] = __builtin_amdgcn_mfma_f32_16x16x32_bf16(Bt[n][k], At[m][k], acc[ai][bj][m][n], 0, 0, 0); __builtin_amdgcn_s_setprio(0); } while (0)
#define PG8_WAIT_V(n) asm volatile("s_waitcnt vmcnt(" #n ")" ::: "memory")
#define PG8_WAIT_L(n) asm volatile("s_waitcnt lgkmcnt(" #n ")" ::: "memory")
#define PG8_BAR __builtin_amdgcn_s_barrier()
#define PG8_SCHED __builtin_amdgcn_sched_barrier(0)
    Unit cur, nxt; int ui = 0;
    if (!S.next(0, cur)) return;
    f32x4 acc[2][2][4][2];
#pragma unroll
    for (int a = 0; a < 2; ++a)
#pragma unroll
        for (int b = 0; b < 2; ++b)
#pragma unroll
            for (int m = 0; m < 4; ++m)
#pragma unroll
                for (int n = 0; n < 2; ++n) acc[a][b][m][n] = (f32x4){0.f, 0.f, 0.f, 0.f};
    bf16x8 At[4][2], B0[2][2], B1[2][2];
    const char* cA = (const char*)g.A + (size_t)cur.pm * tstep; const char* cB = (const char*)g.Bt + (size_t)cur.pn * tstep;
    S.a_ready(cur);
    if constexpr (SP2) {
        PG8_STAGE(PG8_SB(0, 0), cB, voffB); PG8_STAGE(PG8_SB(0, 1), cB + hstep, voffB); PG8_STAGE(PG8_SA(0, 0), cA, voffA); PG8_STAGE(PG8_SA(0, 1), cA + hstep, voffA);
        if (wr == 1) PG8_BAR;
        PG8_WAIT_V(2); PG8_BAR;
        PG8_STAGE(PG8_SB(1, 0), cB + kstep, voffB); PG8_STAGE(PG8_SA(1, 0), cA + kstep, voffA); PG8_STAGE(PG8_SB(1, 1), cB + hstep + kstep, voffB);
        PG8_WAIT_V(6); PG8_BAR;
    } else {
        PG8_STAGE(PG8_SB(0, 0), cB, voffB); PG8_STAGE(PG8_SA(0, 0), cA, voffA); PG8_STAGE(PG8_SB(0, 1), cB + hstep, voffB); PG8_STAGE(PG8_SA(0, 1), cA + hstep, voffA);
        if (wr == 1) PG8_BAR;
        PG8_WAIT_V(4); PG8_BAR;
        PG8_STAGE(PG8_SB(1, 0), cB + kstep, voffB); PG8_STAGE(PG8_SA(1, 0), cA + kstep, voffA); PG8_STAGE(PG8_SB(1, 1), cB + hstep + kstep, voffB);
        PG8_WAIT_V(6); PG8_BAR;
    }
    for (;;) {
        const bool has_next = S.next(ui + 1, nxt);
        const char* nA = has_next ? (const char*)g.A + (size_t)nxt.pm * tstep : cA; const char* nB = has_next ? (const char*)g.Bt + (size_t)nxt.pn * tstep : cB;
        for (int t = 0; t < nt; t += 2) {
            const bool last = (t == nt - 2);
            const char* a1 = cA + (size_t)(t + 1) * kstep;
            const char* a2 = last ? nA : cA + (size_t)(t + 2) * kstep; const char* b2 = last ? nB : cB + (size_t)(t + 2) * kstep;
            const char* a3 = a2 + kstep; const char* b3 = b2 + kstep;
            if (last && has_next) S.a_ready(nxt);
            if constexpr (SP2) {
            PG8_LDB(B0, 0, 0); PG8_LDB(B1, 0, 1); PG8_SCHED; PG8_LDA(At, 0, 0); PG8_STAGE(PG8_SA(1, 1), a1 + hstep, voffA);
            PG8_WAIT_V(8); PG8_WAIT_L(0); PG8_BAR; PG8_MMA(0, 0, At, B0); PG8_MMA(0, 1, At, B1); PG8_BAR; PG8_SCHED;
            PG8_LDA(At, 0, 1); PG8_STAGE(PG8_SB(0, 0), b2, voffB); PG8_STAGE(PG8_SB(0, 1), b2 + hstep, voffB); PG8_STAGE(PG8_SA(0, 0), a2, voffA);
            PG8_WAIT_V(8); PG8_WAIT_L(0); PG8_BAR; PG8_MMA(1, 0, At, B0); PG8_MMA(1, 1, At, B1); PG8_BAR; PG8_SCHED;
            PG8_LDB(B0, 1, 0); PG8_LDB(B1, 1, 1); PG8_SCHED; PG8_LDA(At, 1, 0); PG8_STAGE(PG8_SA(0, 1), a2 + hstep, voffA);
            PG8_WAIT_V(8); PG8_WAIT_L(0); PG8_BAR; PG8_MMA(0, 0, At, B0); PG8_MMA(0, 1, At, B1); PG8_BAR; PG8_SCHED;
            PG8_LDA(At, 1, 1); PG8_STAGE(PG8_SB(1, 0), b3, voffB); PG8_STAGE(PG8_SB(1, 1), b3 + hstep, voffB); PG8_STAGE(PG8_SA(1, 0), a3, voffA);
            PG8_WAIT_V(8); PG8_WAIT_L(0); PG8_BAR; PG8_MMA(1, 0, At, B0); PG8_MMA(1, 1, At, B1); PG8_BAR; PG8_SCHED;
            } else {
            PG8_LDB(B0, 0, 0); PG8_SCHED; PG8_LDA(At, 0, 0); PG8_STAGE(PG8_SA(1, 1), a1 + hstep, voffA);
            PG8_WAIT_L(8); PG8_BAR; PG8_WAIT_L(0); PG8_MMA(0, 0, At, B0); PG8_BAR; PG8_SCHED;
            PG8_LDB(B1, 0, 1); PG8_STAGE(PG8_SB(0, 0), b2, voffB);
            PG8_BAR; PG8_WAIT_L(0); PG8_MMA(0, 1, At, B1); PG8_BAR;
            PG8_LDA(At, 0, 1); PG8_STAGE(PG8_SA(0, 0), a2, voffA);
            PG8_BAR; PG8_WAIT_L(0); PG8_MMA(1, 0, At, B0); PG8_BAR; PG8_SCHED;
            PG8_STAGE(PG8_SB(0, 1), b2 + hstep, voffB);
            PG8_WAIT_V(6); PG8_BAR; PG8_MMA(1, 1, At, B1); PG8_BAR;
            PG8_LDB(B0, 1, 0); PG8_SCHED; PG8_LDA(At, 1, 0); PG8_STAGE(PG8_SA(0, 1), a2 + hstep, voffA);
            PG8_WAIT_L(8); PG8_BAR; PG8_WAIT_L(0); PG8_MMA(0, 0, At, B0); PG8_BAR; PG8_SCHED;
            PG8_LDB(B1, 1, 1); PG8_STAGE(PG8_SB(1, 0), b3, voffB);
            PG8_BAR; PG8_WAIT_L(0); PG8_MMA(0, 1, At, B1); PG8_BAR;
            PG8_LDA(At, 1, 1); PG8_STAGE(PG8_SA(1, 0), a3, voffA);
            PG8_BAR; PG8_WAIT_L(0); PG8_MMA(1, 0, At, B0); PG8_BAR; PG8_SCHED;
            PG8_STAGE(PG8_SB(1, 1), b3 + hstep, voffB);
            PG8_WAIT_V(6); PG8_BAR; PG8_MMA(1, 1, At, B1); PG8_BAR;
            }
        }
        if constexpr (ALIGN_EPI) { if (wr == 0) PG8_BAR; }
        if constexpr (!Epi::AFTER_DRAIN) { E(acc, cur, wr, wc, fr, fq); S.done(cur); }
        if (!has_next) break;
#pragma unroll
        for (int a = 0; a < 2; ++a)
#pragma unroll
            for (int b = 0; b < 2; ++b)
#pragma unroll
                for (int m = 0; m < 4; ++m)
#pragma unroll
                    for (int n = 0; n < 2; ++n) acc[a][b][m][n] = (f32x4){0.f, 0.f, 0.f, 0.f};
        cur = nxt; cA = nA; cB = nB; ++ui;
        if constexpr (ALIGN_EPI) { if (wr == 1) PG8_BAR; }
    }
    PG8_WAIT_V(0);
    if constexpr (!ALIGN_EPI) { if (wr == 0) PG8_BAR; }
    PG8_BAR;
    if constexpr (Epi::AFTER_DRAIN) { E.fused(acc, cur, wr, wc, fr, fq, lds, wid, lane); S.done(cur); }
#undef PG8_SA
#undef PG8_SB
#undef PG8_STAGE
#undef PG8_LDA
#undef PG8_LDB
#undef PG8_MMA
#undef PG8_WAIT_V
#undef PG8_WAIT_L
#undef PG8_BAR
#undef PG8_SCHED
}
}

#ifndef PG8_SP2
#define PG8_SP2 true
#endif
#ifndef PG8_ALIGN
#define PG8_ALIGN true
#endif
#ifndef MK_MODE
#define MK_MODE 1
#endif

constexpr int D = 1024, NB = 16, SEQ = 4096, DSEQ = 16, NPROJ = 3200, NPAD = 3328;
constexpr int MP = NB * SEQ;
constexpr int MS = NB * DSEQ;
constexpr int MT = MP + MS;
constexpr int NPHASE = 10;
constexpr float EPS = 1e-6f;
constexpr int ZC_P = 0, ZC_ZP = 256, ZC_GB = 512, ZC_GC = 896, ZC_HX = 1280, ZC_ZC = 1664, ZC_U = 2048, ZC_V = 2432, ZC_ZG = 2816;
constexpr size_t OFF_YP = 0, OFF_YS = (size_t)MP * D, OFF_POOL_P = OFF_YS + (size_t)MS * D, OFF_CONV_P = OFF_POOL_P + 2 * 16 * 15 * 256,
                 OFF_POOL_S = OFF_CONV_P + 2 * 16 * 2 * 384, OFF_CONV_S = OFF_POOL_S + 2 * 16 * 15 * 256, OFF_V_S = OFF_CONV_S + 2 * 16 * 2 * 384;
constexpr size_t MiB = 1u << 20;
constexpr size_t WS_CTL = 0, CTL_ZERO_BYTES = 1 * MiB;
constexpr size_t WS_MOD = 1 * MiB;
constexpr size_t WS_WST = 2 * MiB;
constexpr size_t WS_WPT = 3 * MiB;
constexpr size_t WS_WOUT = 4 * MiB;
constexpr size_t WS_WIN = 8 * MiB;
constexpr size_t WIN_BYTES = (size_t)NPAD * D * 2;
constexpr size_t WS_H = 32 * MiB;
constexpr size_t WS_YC = 161 * MiB;
constexpr size_t WS_Z = 290 * MiB;
constexpr size_t WS_END = WS_Z + (size_t)MT * NPAD * 2;
static_assert(WS_WIN + 2 * WIN_BYTES <= WS_H && WS_H + (size_t)MT * D * 2 <= WS_YC && WS_YC + (size_t)MT * D * 2 <= WS_Z && WS_END <= 1024 * MiB, "d_ws map");

constexpr int NWAVES = 8;
constexpr int LDS_BYTES = 147456;

#define GAS __attribute__((address_space(1)))
#define CAS __attribute__((address_space(4)))
#define LAS __attribute__((address_space(3)))
typedef unsigned short bf16;
typedef unsigned v4u __attribute__((ext_vector_type(4)));
typedef unsigned v2u __attribute__((ext_vector_type(2)));
typedef float f32x4 __attribute__((ext_vector_type(4)));
typedef short bf16x8 __attribute__((ext_vector_type(8)));
#define LDS_WAIT() asm volatile("s_waitcnt lgkmcnt(0)" ::: "memory")

__device__ __forceinline__ unsigned f2bf(float f) { unsigned u = __builtin_bit_cast(unsigned, f); return (u + 0x7fffu + ((u >> 16) & 1u)) >> 16; }
__device__ __forceinline__ unsigned pk2(float lo, float hi) { return f2bf(lo) | (f2bf(hi) << 16); }
__device__ __forceinline__ float bf2f(unsigned v) { return __builtin_bit_cast(float, v << 16); }
__device__ __forceinline__ float silu_f(float x) { return x / (1.0f + __expf(-x)); }
__device__ __forceinline__ void unpack8(const v4u p, float (&f)[8]) {
    f[0] = __builtin_bit_cast(float, p.x << 16); f[1] = __builtin_bit_cast(float, p.x & 0xffff0000u);
    f[2] = __builtin_bit_cast(float, p.y << 16); f[3] = __builtin_bit_cast(float, p.y & 0xffff0000u);
    f[4] = __builtin_bit_cast(float, p.z << 16); f[5] = __builtin_bit_cast(float, p.z & 0xffff0000u);
    f[6] = __builtin_bit_cast(float, p.w << 16); f[7] = __builtin_bit_cast(float, p.w & 0xffff0000u); }
__device__ __forceinline__ v4u pack8(const float (&f)[8]) { v4u r; r.x = pk2(f[0], f[1]); r.y = pk2(f[2], f[3]); r.z = pk2(f[4], f[5]); r.w = pk2(f[6], f[7]); return r; }
__device__ __forceinline__ float wave_sum(float v) {
#pragma unroll
    for (int o = 1; o < 64; o <<= 1) v += __shfl_xor(v, o);
    return v;
}

struct Frame {
    LAS unsigned char* lds;
    int tid, lane, wave, vcu, G;
    const float *x_prompt, *x_sample, *state_pool, *state_conv, *c_prompt, *c_sample, *norm_g, *w_ada, *b_ada, *w_in, *w_pool, *pool_scale, *w_conv, *v_norm_g, *v_norm_b, *w_s, *b_s, *w_out, *final_g;
    float* out;
    float* mod; bf16 *WST, *WPT, *WOUT, *WIN, *H, *YC, *Z;
};

__device__ __forceinline__ void p0_transpose_item(const float* W, int K, int N, bf16* WT, LAS float* scr, int item, int lane) {
    const int nblk = N / 32, kb = item / nblk, nb = item % nblk, k0 = 64 * kb, n0 = 32 * nb;
#pragma unroll 8
    for (int i = 0; i < 32; ++i) { const int kk = 2 * i + (lane >> 5); scr[kk * 33 + (lane & 31)] = W[(size_t)(k0 + kk) * N + n0 + (lane & 31)]; }
    LDS_WAIT(); asm volatile("" ::: "memory");
    const int c = lane & 7;
#pragma unroll
    for (int j = 0; j < 4; ++j) { const int n = (lane >> 3) + 8 * j; const LAS float* s = scr + (8 * c) * 33 + n;
        v4u o; o.x = pk2(s[0 * 33], s[1 * 33]); o.y = pk2(s[2 * 33], s[3 * 33]); o.z = pk2(s[4 * 33], s[5 * 33]); o.w = pk2(s[6 * 33], s[7 * 33]);
        *(GAS v4u*)(WT + (size_t)(n0 + n) * K + k0 + 8 * c) = o; }
    LDS_WAIT(); asm volatile("" ::: "memory");
}
__device__ __forceinline__ void p0_mod_item(const Frame& F, int item) {
    const int l = item / 48, cb = item % 48;
    LAS float* S = (LAS float*)F.lds;
    for (int idx = F.tid; idx < 32 * 1024; idx += 512) { const int r = idx & 31, k = idx >> 5;
        const float cv = r < 16 ? F.c_prompt[r * 1024 + k] : F.c_sample[(r - 16) * 1024 + k]; S[idx] = silu_f(cv); }
    __syncthreads();
    float acc[32];
#pragma unroll
    for (int r = 0; r < 32; ++r) acc[r] = 0.f;
    const float* wp = F.w_ada + (size_t)l * 1024 * 3072 + cb * 64 + F.lane;
#pragma unroll 2
    for (int kk = 0; kk < 128; ++kk) { const int k = F.wave * 128 + kk; const float wv = wp[(size_t)k * 3072];
        const LAS f32x4* sp = (const LAS f32x4*)(S + k * 32);
#pragma unroll
        for (int q = 0; q < 8; ++q) { const f32x4 s = sp[q]; acc[4 * q + 0] += s.x * wv; acc[4 * q + 1] += s.y * wv; acc[4 * q + 2] += s.z * wv; acc[4 * q + 3] += s.w * wv; } }
    __syncthreads();
    LAS float* red = (LAS float*)F.lds;
#pragma unroll
    for (int r = 0; r < 32; ++r) red[(F.wave * 32 + r) * 64 + F.lane] = acc[r];
    __syncthreads();
    for (int o = F.tid; o < 2048; o += 512) { const int r = o >> 6, ln = o & 63; float s = 0.f;
#pragma unroll
        for (int w = 0; w < 8; ++w) s += red[(w * 32 + r) * 64 + ln];
        F.mod[((size_t)l * 32 + r) * 3072 + cb * 64 + ln] = s + F.b_ada[l * 3072 + cb * 64 + ln]; }
    __syncthreads();
}
__device__ __forceinline__ void p0_prologue(const Frame& F) {
    for (int it = F.vcu; it < 96; it += F.G) p0_mod_item(F, it);
    LAS float* scr = (LAS float*)(F.lds + F.wave * 16384);
    const int gw = F.vcu * NWAVES + F.wave, NGW = F.G * NWAVES;
    constexpr int I_IN = (D / 64) * (NPROJ / 32), I_OUT = (D / 64) * (D / 32);
    for (int it = gw; it < 2 * I_IN + 2 * I_OUT; it += NGW) {
        int r = it;
        if (r < 2 * I_IN) { const int l = r / I_IN; r -= l * I_IN; p0_transpose_item(F.w_in + (size_t)l * D * NPROJ, D, NPROJ, F.WIN + (size_t)l * NPAD * D, scr, r, F.lane); }
        else { r -= 2 * I_IN; const int l = r / I_OUT; r -= l * I_OUT; p0_transpose_item(F.w_out + (size_t)l * D * D, D, D, F.WOUT + (size_t)l * D * D, scr, r, F.lane); }
    }
    const int gt = F.vcu * 512 + F.tid, NGT = F.G * 512;
    for (int i = gt; i < 2 * (NPAD - NPROJ) * D / 8; i += NGT) {
        const int l = i / ((NPAD - NPROJ) * D / 8), j = i % ((NPAD - NPROJ) * D / 8);
        *(GAS v4u*)(F.WIN + (size_t)l * NPAD * D + (size_t)NPROJ * D + (size_t)j * 8) = (v4u){0u, 0u, 0u, 0u}; }
    for (int i = gt; i < 2 * 6 * 128 * 128; i += NGT) {
        const int s = i & 127, t = (i >> 7) & 127; F.WST[i] = (bf16)(((s >> 6) <= (t >> 6)) ? f2bf(F.w_s[i]) : 0u); }
    for (int i = gt; i < 2 * 4 * 64 * 64; i += NGT) {
        const int d = i & 63, e = (i >> 6) & 63, lg = i >> 12; F.WPT[i] = (bf16)f2bf(F.w_pool[(lg * 64 + d) * 64 + e]); }
}

__device__ __forceinline__ void norm_phase(const Frame& F, int l) {
    const int gw = F.vcu * NWAVES + F.wave, NGW = F.G * NWAVES;
    const float* modl = F.mod + (size_t)l * 32 * 3072; const float* ng = F.norm_g + l * 1024;
    for (int row = gw; row < MT; row += NGW) {
        const float* xr; int r;
        if (row < MP) { xr = (l == 0 ? F.x_prompt : F.out) + (size_t)row * D; r = row >> 12; }
        else { xr = (l == 0 ? F.x_sample + (size_t)(row - MP) * D : F.out + (size_t)row * D); r = 16 + ((row - MP) >> 4); }
        const GAS f32x4* xp = (const GAS f32x4*)xr + F.lane;
        f32x4 v[4]; float ss = 0.f;
#pragma unroll
        for (int j = 0; j < 4; ++j) { v[j] = xp[64 * j]; ss += (v[j].x * v[j].x + v[j].y * v[j].y) + (v[j].z * v[j].z + v[j].w * v[j].w); }
        const float rstd = 1.0f / sqrtf(wave_sum(ss) * (1.0f / D) + EPS);
        const float* mr = modl + (size_t)r * 3072;
        GAS v2u* o8 = (GAS v2u*)(F.H + (size_t)row * D) + F.lane;
#pragma unroll
        for (int j = 0; j < 4; ++j) { const int col = 4 * F.lane + 256 * j;
            const f32x4 g = *(const f32x4*)(ng + col), sh = *(const f32x4*)(mr + col), sc = *(const f32x4*)(mr + 1024 + col);
            const f32x4 y = (v[j] * rstd * g) * (sc + 1.0f) + sh;
            v2u w; w.x = pk2(y.x, y.y); w.y = pk2(y.z, y.w); o8[64 * j] = w; }
    }
}
__device__ __forceinline__ void final_norm_phase(const Frame& F) {
    const int gw = F.vcu * NWAVES + F.wave, NGW = F.G * NWAVES;
    for (int row = gw; row < MT; row += NGW) {
        GAS f32x4* xp = (GAS f32x4*)(F.out + (size_t)row * D) + F.lane;
        f32x4 v[4]; float ss = 0.f;
#pragma unroll
        for (int j = 0; j < 4; ++j) { v[j] = xp[64 * j]; ss += (v[j].x * v[j].x + v[j].y * v[j].y) + (v[j].z * v[j].z + v[j].w * v[j].w); }
        const float rstd = 1.0f / sqrtf(wave_sum(ss) * (1.0f / D) + EPS);
#pragma unroll
        for (int j = 0; j < 4; ++j) { const f32x4 g = *(const f32x4*)(F.final_g + 4 * F.lane + 256 * j); xp[64 * j] = v[j] * rstd * g; }
    }
}

constexpr int PB_OFF = 0, DM_OFF = 73728, DM_PITCH = 528, VN_PITCH = 272;
__device__ __forceinline__ void mixer_tile(const Frame& F, int l, int ti) {
    const bool samp = ti >= 512;
    const int b = samp ? ti - 512 : ti >> 5, c = samp ? 0 : ti & 31;
    const int nTok = samp ? 16 : 128;
    const size_t row0 = samp ? (size_t)MP + b * 16 : (size_t)b * SEQ + c * 128;
    const int pos0 = samp ? 1024 : c * 128;
    const bf16* Zt = F.Z + row0 * NPAD;
    bf16* Yt = F.YC + row0 * D;
    LAS bf16* pbuf = (LAS bf16*)(F.lds + PB_OFF);
    LAS unsigned char* dmat = F.lds + DM_OFF;
    const int fr = F.lane & 15, fq = F.lane >> 4;
    for (int idx = F.tid; idx < (15 + nTok) * 32; idx += 512) {
        const int r = idx >> 5, ch8 = (idx & 31) * 8, t = r - 15;
        v4u val = (v4u){0u, 0u, 0u, 0u};
        if (t >= 0 || (!samp && c > 0)) val = *(const GAS v4u*)(Zt + (ptrdiff_t)t * NPAD + ZC_P + ch8);
        else if (samp) { const float* sp = F.state_pool + ((size_t)(l * 16 + b) * 15 + r) * 256 + ch8; const f32x4 a = *(const f32x4*)sp, bb = *(const f32x4*)(sp + 4);
            val.x = pk2(a.x, a.y); val.y = pk2(a.z, a.w); val.z = pk2(bb.x, bb.y); val.w = pk2(bb.z, bb.w); }
        *(LAS v4u*)(pbuf + r * 256 + ch8) = val;
    }
    __syncthreads();
    {
        const int ch = F.tid & 255, seg = F.tid >> 8, g = ch >> 6, w = 2 << g;
        const int t0 = seg * 64, len = samp ? (seg == 0 ? 16 : 0) : 64;
        if (len > 0) {
            float S = 0.f;
            for (int i = 1; i < w; ++i) S += bf2f(pbuf[(15 + t0 - i) * 256 + ch]);
            for (int t = t0; t < t0 + len; ++t) {
                const float pv = bf2f(pbuf[(15 + t) * 256 + ch]);
                S += pv;
                const int pc = pos0 + t + 1; const float cnt = (float)(pc < w ? pc : w);
                const float dv = S / cnt - pv;
                *(LAS bf16*)(dmat + t * DM_PITCH + ch * 2) = (bf16)f2bf(dv);
                S -= bf2f(pbuf[(15 + t - w + 1) * 256 + ch]);
            }
        }
    }
    __syncthreads();
    if (F.wave * 16 < nTok) {
        const int t = F.wave * 16 + fr;
        const bf16* zr = Zt + (size_t)t * NPAD; bf16* yr = Yt + (size_t)t * D;
        const bf16* WpT = F.WPT + l * 16384; const float* ps = F.pool_scale + l * 256;
#pragma unroll 1
        for (int g = 0; g < 4; ++g) {
            bf16x8 bfr[2];
#pragma unroll
            for (int kk = 0; kk < 2; ++kk) bfr[kk] = *(const LAS bf16x8*)(dmat + t * DM_PITCH + (g * 64 + 32 * kk + 8 * fq) * 2);
            f32x4 acc[4];
#pragma unroll
            for (int et = 0; et < 4; ++et) { const int e = 32 * (et >> 1) + 8 * (fr >> 2) + 4 * (et & 1) + (fr & 3);
                acc[et] = (f32x4){0.f, 0.f, 0.f, 0.f};
#pragma unroll
                for (int kk = 0; kk < 2; ++kk) { const bf16x8 a = *(const GAS bf16x8*)(WpT + (g * 64 + e) * 64 + 32 * kk + 8 * fq);
                    acc[et] = __builtin_amdgcn_mfma_f32_16x16x32_bf16(a, bfr[kk], acc[et], 0, 0, 0); } }
#pragma unroll
            for (int hh = 0; hh < 2; ++hh) { const int ch = g * 64 + 32 * hh + 8 * fq;
                const v4u zp = *(const GAS v4u*)(zr + ZC_ZP + ch); const f32x4 s0 = *(const f32x4*)(ps + ch), s1 = *(const f32x4*)(ps + ch + 4);
                float zv[8], o[8]; unpack8(zp, zv);
#pragma unroll
                for (int i = 0; i < 4; ++i) { o[i] = acc[2 * hh][i] * s0[i] * silu_f(zv[i]); o[4 + i] = acc[2 * hh + 1][i] * s1[i] * silu_f(zv[4 + i]); }
                *(GAS v4u*)(yr + ch) = pack8(o); }
        }
    }
    if (samp || c == 31) {
        float* dst = F.out + (samp ? OFF_POOL_S : OFF_POOL_P) + (size_t)(l * 16 + b) * 15 * 256;
        const int rbase = samp ? 16 : 128;
        for (int idx = F.tid; idx < 15 * 256; idx += 512) dst[idx] = bf2f(pbuf[rbase * 256 + idx]);
    }
    __syncthreads();
    LAS unsigned char* vnT = F.lds;
    {
        float gm[6], be[6];
#pragma unroll
        for (int j = 0; j < 3; ++j) { const int cc = 2 * F.lane + 128 * j; gm[2 * j] = F.v_norm_g[l * 384 + cc]; gm[2 * j + 1] = F.v_norm_g[l * 384 + cc + 1]; be[2 * j] = F.v_norm_b[l * 384 + cc]; be[2 * j + 1] = F.v_norm_b[l * 384 + cc + 1]; }
        if (samp) for (int idx = F.tid; idx < 768; idx += 512) *(LAS v4u*)(vnT + (idx >> 1) * VN_PITCH + 32 + (idx & 1) * 16) = (v4u){0u, 0u, 0u, 0u};
        for (int tt = F.wave; tt < nTok; tt += 8) {
            const bf16* vr = Zt + (size_t)tt * NPAD + ZC_V + 2 * F.lane;
            float x[6]; float s = 0.f;
#pragma unroll
            for (int j = 0; j < 3; ++j) { const unsigned wv = *(const GAS unsigned*)(vr + 128 * j); x[2 * j] = __builtin_bit_cast(float, wv << 16); x[2 * j + 1] = __builtin_bit_cast(float, wv & 0xffff0000u); s += x[2 * j] + x[2 * j + 1]; }
            const float mu = wave_sum(s) * (1.0f / 384.0f); float q = 0.f;
#pragma unroll
            for (int i = 0; i < 6; ++i) { x[i] -= mu; q += x[i] * x[i]; }
            const float rstd = 1.0f / sqrtf(wave_sum(q) * (1.0f / 384.0f) + EPS);
#pragma unroll
            for (int j = 0; j < 3; ++j)
#pragma unroll
                for (int e = 0; e < 2; ++e) { const int cc = 2 * F.lane + 128 * j + e; const float y = x[2 * j + e] * rstd * gm[2 * j + e] + be[2 * j + e];
                    *(LAS bf16*)(vnT + cc * VN_PITCH + tt * 2) = (bf16)f2bf(y);
                    if (samp) F.out[OFF_V_S + ((size_t)(l * 16 + b) * 16 + tt) * 384 + cc] = y; }
        }
    }
    __syncthreads();
    if (F.wave * 16 < nTok) {
        const int t = F.wave * 16 + fr; const int nk = samp ? 1 : 4;
        const bf16* zr = Zt + (size_t)t * NPAD; bf16* yr = Yt + (size_t)t * D;
        const bf16* Wl = F.WST + (size_t)l * 6 * 16384;
#pragma unroll 1
        for (int h = 0; h < 6; ++h) {
            bf16x8 bfr[4];
#pragma unroll
            for (int kk = 0; kk < 4; ++kk) bfr[kk] = (kk < nk) ? *(const GAS bf16x8*)(Wl + (size_t)(h * 128 + t) * 128 + 32 * kk + 8 * fq) : (bf16x8){0, 0, 0, 0, 0, 0, 0, 0};
            f32x4 acc[4];
#pragma unroll
            for (int ct = 0; ct < 4; ++ct) { const int chrow = h * 64 + 32 * (ct >> 1) + 8 * (fr >> 2) + 4 * (ct & 1) + (fr & 3);
                acc[ct] = (f32x4){0.f, 0.f, 0.f, 0.f};
#pragma unroll
                for (int kk = 0; kk < 4; ++kk) if (kk < nk) { const bf16x8 a = *(const LAS bf16x8*)(vnT + chrow * VN_PITCH + (32 * kk + 8 * fq) * 2);
                    acc[ct] = __builtin_amdgcn_mfma_f32_16x16x32_bf16(a, bfr[kk], acc[ct], 0, 0, 0); } }
            const float bsv = F.b_s[(l * 6 + h) * 128 + t];
#pragma unroll
            for (int hh = 0; hh < 2; ++hh) { const int ch = h * 64 + 32 * hh + 8 * fq;
                const v4u up = *(const GAS v4u*)(zr + ZC_U + ch), zg = *(const GAS v4u*)(zr + ZC_ZG + ch);
                float uv[8], zv[8], o[8]; unpack8(up, uv); unpack8(zg, zv);
#pragma unroll
                for (int i = 0; i < 4; ++i) { o[i] = uv[i] * (acc[2 * hh][i] + bsv) * silu_f(zv[i]); o[4 + i] = uv[4 + i] * (acc[2 * hh + 1][i] + bsv) * silu_f(zv[4 + i]); }
                *(GAS v4u*)(yr + 640 + ch) = pack8(o); }
        }
    }
    if (F.tid < 384) {
        const int chunk = F.tid % 48, seg = F.tid / 48, ch = chunk * 8, t0 = seg * 16;
        if (t0 < nTok) {
            float w0[8], w1[8], w2[8], q2[8], q1[8];
            const float* wc = F.w_conv + l * 3 * 384 + ch;
#pragma unroll
            for (int i = 0; i < 8; ++i) { w0[i] = wc[i]; w1[i] = wc[384 + i]; w2[i] = wc[768 + i]; }
#pragma unroll
            for (int hrow = 0; hrow < 2; ++hrow) {
                const int t = t0 - 2 + hrow; float qq[8];
                if (t >= 0 || (!samp && c > 0)) { const bf16* zr = Zt + (ptrdiff_t)t * NPAD; float a[8], bq[8];
                    unpack8(*(const GAS v4u*)(zr + ZC_GC + ch), a); unpack8(*(const GAS v4u*)(zr + ZC_HX + ch), bq);
#pragma unroll
                    for (int i = 0; i < 8; ++i) qq[i] = a[i] * bq[i]; }
                else if (samp) { const float* sp = F.state_conv + ((size_t)(l * 16 + b) * 2 + (2 + t)) * 384 + ch;
#pragma unroll
                    for (int i = 0; i < 8; ++i) qq[i] = sp[i]; }
                else {
#pragma unroll
                    for (int i = 0; i < 8; ++i) qq[i] = 0.f; }
#pragma unroll
                for (int i = 0; i < 8; ++i) { if (hrow == 0) q2[i] = qq[i]; else q1[i] = qq[i]; }
            }
            float* cdst = F.out + (samp ? OFF_CONV_S : OFF_CONV_P) + (size_t)(l * 16 + b) * 2 * 384 + ch;
            const bool wstate = samp || (c == 31 && t0 == 112);
            for (int t = t0; t < t0 + 16; ++t) {
                const bf16* zr = Zt + (size_t)t * NPAD; float gb[8], gc[8], hx[8], zc[8], o[8], q0[8];
                unpack8(*(const GAS v4u*)(zr + ZC_GB + ch), gb); unpack8(*(const GAS v4u*)(zr + ZC_GC + ch), gc);
                unpack8(*(const GAS v4u*)(zr + ZC_HX + ch), hx); unpack8(*(const GAS v4u*)(zr + ZC_ZC + ch), zc);
#pragma unroll
                for (int i = 0; i < 8; ++i) { q0[i] = gc[i] * hx[i]; o[i] = gb[i] * (w0[i] * q2[i] + w1[i] * q1[i] + w2[i] * q0[i]) * silu_f(zc[i]); }
                *(GAS v4u*)(Yt + (size_t)t * D + 256 + ch) = pack8(o);
                if (wstate && t >= t0 + 14) {
#pragma unroll
                    for (int i = 0; i < 8; ++i) cdst[(t - (t0 + 14)) * 384 + i] = q0[i]; }
#pragma unroll
                for (int i = 0; i < 8; ++i) { q2[i] = q1[i]; q1[i] = q0[i]; }
            }
        }
    }
    __syncthreads();
}
__device__ __forceinline__ void mixer_phase(const Frame& F, int l) {
    for (int ti = F.vcu; ti < 512 + 16; ti += F.G) mixer_tile(F, l, ti);
}

struct Args { const float* in[19]; float* out; unsigned char* ws; int ph_lo, ph_hi; };
__global__ void __launch_bounds__(NWAVES * 64, 2) fwd(Args args) {
    extern __shared__ __attribute__((aligned(16))) unsigned char lds_raw[];
    const int lo = args.ph_lo, hi = args.ph_hi;
#define MAKE_FRAME() Frame F; { int tid_ = threadIdx.x; asm volatile("" : "+v"(tid_)); const CAS Args* ap = (const CAS Args*)__builtin_amdgcn_kernarg_segment_ptr(); asm volatile("" : "+s"(ap)); \
    F.lds = (LAS unsigned char*)lds_raw; F.tid = tid_; F.lane = F.tid & 63; F.wave = __builtin_amdgcn_readfirstlane(F.tid >> 6); \
    F.G = gridDim.x; { const int bx = blockIdx.x; F.vcu = (F.G % 8 == 0) ? (bx % 8) * (F.G / 8) + bx / 8 : bx; } \
    F.x_prompt = ap->in[0]; F.x_sample = ap->in[1]; F.state_pool = ap->in[2]; F.state_conv = ap->in[3]; F.c_prompt = ap->in[4]; F.c_sample = ap->in[5]; \
    F.norm_g = ap->in[6]; F.w_ada = ap->in[7]; F.b_ada = ap->in[8]; F.w_in = ap->in[9]; F.w_pool = ap->in[10]; F.pool_scale = ap->in[11]; F.w_conv = ap->in[12]; \
    F.v_norm_g = ap->in[13]; F.v_norm_b = ap->in[14]; F.w_s = ap->in[15]; F.b_s = ap->in[16]; F.w_out = ap->in[17]; F.final_g = ap->in[18]; \
    F.out = ap->out; unsigned char* ws = ap->ws; \
    F.mod = (float*)(ws + WS_MOD); F.WST = (bf16*)(ws + WS_WST); F.WPT = (bf16*)(ws + WS_WPT); F.WOUT = (bf16*)(ws + WS_WOUT); F.WIN = (bf16*)(ws + WS_WIN); \
    F.H = (bf16*)(ws + WS_H); F.YC = (bf16*)(ws + WS_YC); F.Z = (bf16*)(ws + WS_Z); }
#if MK_MODE == 1
    cg::grid_group grid = cg::this_grid();
#define GRID_BAR() grid.sync()
#else
#define GRID_BAR() do {} while (0)
#endif
#define IN(k) (lo <= (k) && (k) < hi)
#define SEAM(k) do { if (IN(k) && IN((k) + 1)) GRID_BAR(); } while (0)

    if (IN(0)) { MAKE_FRAME(); p0_prologue(F); SEAM(0); }
#pragma unroll 1
    for (int l = 0; l < 2; ++l) {
        const int pb = 1 + 4 * l;
        if (IN(pb)) { MAKE_FRAME(); norm_phase(F, l); SEAM(pb); }
        if (IN(pb + 1)) {
            MAKE_FRAME(); pg8::Gemm g{F.H, F.WIN + (size_t)l * NPAD * D, MT, NPAD, D}; pg8::StaticOrder S; S.init(MT, NPAD, F.G, (int)blockIdx.x);
            pg8::EpiZ E{F.Z, NPAD};
            pg8::gemm_phase<pg8::EpiZ, pg8::StaticOrder, PG8_ALIGN, PG8_SP2>(F.lds, g, S, E);
            SEAM(pb + 1);
        }
        if (IN(pb + 2)) { MAKE_FRAME(); mixer_phase(F, l); SEAM(pb + 2); }
        if (IN(pb + 3)) {
            MAKE_FRAME(); pg8::Gemm g{F.YC, F.WOUT + (size_t)l * D * D, MT, D, D}; pg8::StaticOrder S; S.init(MT, D, F.G, (int)blockIdx.x);
            pg8::EpiRes E{l == 0 ? F.x_prompt : F.out, l == 0 ? F.x_sample : F.out + (size_t)MP * D, F.out, F.mod + (size_t)l * 32 * 3072 + 2048, MP};
            pg8::gemm_phase<pg8::EpiRes, pg8::StaticOrder, PG8_ALIGN, PG8_SP2>(F.lds, g, S, E);
            SEAM(pb + 3);
        }
    }
    if (IN(9)) { MAKE_FRAME(); final_norm_phase(F); }
#undef IN
#undef SEAM
}

extern "C" void kernel_launch(void* const* d_in, const int* in_sizes, int n_in, void* d_out, int out_size, void* d_ws, size_t ws_size, hipStream_t stream) {
    static int grid = 0;
    if (grid == 0) {
        if (n_in != 19 || ws_size < WS_END) { fprintf(stderr, "kernel_launch: expected 19 inputs and >= %zu bytes of workspace; got n_in %d, ws %zu\n", (size_t)WS_END, n_in, ws_size); grid = -1; return; }
        int dev = 0, cus = 0, per_cu = 0;
        if (hipGetDevice(&dev) != hipSuccess || hipDeviceGetAttribute(&cus, hipDeviceAttributeMultiprocessorCount, dev) != hipSuccess) { grid = -1; return; }
        if (hipFuncSetAttribute((const void*)fwd, hipFuncAttributeMaxDynamicSharedMemorySize, LDS_BYTES) != hipSuccess) { fprintf(stderr, "kernel_launch: hipFuncSetAttribute failed\n"); grid = -1; return; }
        if (hipOccupancyMaxActiveBlocksPerMultiprocessor(&per_cu, (const void*)fwd, NWAVES * 64, LDS_BYTES) != hipSuccess || per_cu < 1) { fprintf(stderr, "kernel_launch: occupancy query says %d blocks per CU\n", per_cu); (void)hipGetLastError(); per_cu = 1; }
        grid = cus;
    }
    if (grid < 0) return;
    (void)hipMemsetAsync((char*)d_ws + WS_CTL, 0, CTL_ZERO_BYTES, stream);
    Args a{};
    for (int i = 0; i < 19; ++i) a.in[i] = (const float*)d_in[i];
    a.out = (float*)d_out; a.ws = (unsigned char*)d_ws;
#if MK_MODE == 0
    for (int ph = 0; ph < NPHASE; ++ph) { a.ph_lo = ph; a.ph_hi = ph + 1; hipLaunchKernelGGL(fwd, dim3(grid), dim3(NWAVES * 64), LDS_BYTES, stream, a);
        const hipError_t le = hipPeekAtLastError(); if (le != hipSuccess) { fprintf(stderr, "kernel_launch: launch %d failed: %s\n", ph, hipGetErrorName(le)); break; } }
#else
    a.ph_lo = 0; a.ph_hi = NPHASE;
    void* kargs[] = {&a};
    const hipError_t le = hipLaunchCooperativeKernel((const void*)fwd, dim3(grid), dim3(NWAVES * 64), kargs, LDS_BYTES, stream);
    if (le != hipSuccess) fprintf(stderr, "kernel_launch: cooperative launch failed: %s (grid %d)\n", hipGetErrorName(le), grid);
#endif
}
```

```cpp
#include <hip/hip_runtime.h>
#include <hip/hip_cooperative_groups.h>
#include <cstdio>
#include <cstdint>
#include <cstddef>
namespace cg = cooperative_groups;
namespace pg8 {
#define PG8_LAS __attribute__((address_space(3)))
typedef unsigned short bf16_t;
typedef short bf16x8 __attribute__((ext_vector_type(8)));
typedef float f32x4 __attribute__((ext_vector_type(4)));
typedef unsigned u32x4 __attribute__((ext_vector_type(4)));
constexpr int BM = 256, BK = 64, HALF = 128, HTB = HALF * BK * 2  , STAGE_BYTES = 8 * HTB, NXCD = 8, WGM = 8;

__host__ __device__ __forceinline__ int lds_byte(int r, int c) { const int st = (r >> 4) * 2 + (c >> 5), rr = r & 15, cc = c & 31, ob = rr * 64 + cc * 2; return st * 1024 + (ob ^ (((ob >> 9) & 1) << 5)); }
__host__ __device__ __forceinline__ void stage_rc(int b, int& R, int& C) { const int st = b / 1024, sb = b % 1024, swz = sb ^ (((sb >> 9) & 1) << 5); R = (st >> 1) * 16 + swz / 64; C = (st & 1) * 32 + (swz % 64) / 2; }
__host__ __device__ __forceinline__ int perm32(int rho) { const int n = rho >> 4, i = rho & 15; return 8 * (i >> 2) + 4 * n + (i & 3); }

struct Unit { int pm, pn; };
struct Gemm { const bf16_t* A; const bf16_t* Bt; int M, N, K; };

struct StaticOrder {
    int nM, nN, nwg, G, c;
    __host__ __device__ void init(int M, int N, int G_, int c_) { nM = M / BM; nN = N / BM; nwg = nM * nN; G = G_; c = c_; }
    __host__ __device__ bool next(int i, Unit& u) const {
        const long L = (long)i * G + c; if (L >= nwg) return false;
        int wgid = (int)L; { const int q = nwg / NXCD, r = nwg % NXCD, xcd = wgid % NXCD, off = wgid / NXCD; wgid = (xcd < r ? xcd * (q + 1) : r * (q + 1) + (xcd - r) * q) + off; }
        const int nig = WGM * nN, gid = wgid / nig, fm = gid * WGM, gsz = (nM - fm) < WGM ? (nM - fm) : WGM;
        u.pm = fm + ((wgid % nig) % gsz); u.pn = (wgid % nig) / gsz; return true;
    }
    __device__ __forceinline__ void a_ready(const Unit&) const {}
    __device__ __forceinline__ void done(const Unit&) const {}
};


__device__ __forceinline__ unsigned cvt_pk_bf16(float lo, float hi) { unsigned r; asm volatile("v_cvt_pk_bf16_f32 %0, %1, %2" : "=v"(r) : "v"(lo), "v"(hi)); return r; }

struct EpiZ {
    static constexpr bool PERM = true, AFTER_DRAIN = false;
    bf16_t* O; int ldc;
    __device__ __forceinline__ void operator()(const f32x4 (&acc)[2][2][4][2], const Unit& u, int wr, int wc, int fr, int fq) const {
        const int row0 = u.pm * BM + wr * 64 + fr, col0 = u.pn * BM + wc * 32 + 8 * fq;
#pragma unroll
        for (int ai = 0; ai < 2; ++ai)
#pragma unroll
            for (int m = 0; m < 4; ++m) { bf16_t* rowp = O + (size_t)(row0 + ai * HALF + m * 16) * ldc + col0;
#pragma unroll
                for (int bj = 0; bj < 2; ++bj) { const f32x4 v0 = acc[ai][bj][m][0], v1 = acc[ai][bj][m][1];
                    u32x4 w; w.x = cvt_pk_bf16(v0[0], v0[1]); w.y = cvt_pk_bf16(v0[2], v0[3]); w.z = cvt_pk_bf16(v1[0], v1[1]); w.w = cvt_pk_bf16(v1[2], v1[3]);
                    *(u32x4*)(rowp + bj * HALF) = w; } }
    }
};
struct EpiRes {
    static constexpr bool PERM = false, AFTER_DRAIN = false;
    const float* baseP; const float* baseS; float* out; const float* gate; int MP;
    __device__ __forceinline__ void operator()(const f32x4 (&acc)[2][2][4][2], const Unit& u, int wr, int wc, int fr, int fq) const {
        const int col0 = u.pn * BM + wc * 32 + 4 * fq;
#pragma unroll
        for (int ai = 0; ai < 2; ++ai)
#pragma unroll
            for (int m = 0; m < 4; ++m) {
                const int grow = u.pm * BM + ai * HALF + wr * 64 + m * 16 + fr;
                const int r = grow < MP ? (grow >> 12) : 16 + ((grow - MP) >> 4);
                const float* bp = grow < MP ? baseP + (size_t)grow * 1024 : baseS + (size_t)(grow - MP) * 1024;
                float* op = out + (size_t)grow * 1024; const float* gp = gate + (size_t)r * 3072;
#pragma unroll
                for (int bj = 0; bj < 2; ++bj)
#pragma unroll
                    for (int n = 0; n < 2; ++n) { const int c = col0 + bj * HALF + n * 16;
                        const f32x4 g = *(const f32x4*)(gp + c), b = *(const f32x4*)(bp + c);
                        *(f32x4*)(op + c) = b + g * acc[ai][bj][m][n]; }
                asm volatile("" ::: "memory"); }
    }
};

template <class Epi, class Sched, bool ALIGN_EPI = false, bool SP2 = false>
__device__ __forceinline__ void gemm_phase(PG8_LAS unsigned char* lds, const Gemm g, const Sched& S, const Epi& E) {
    int tid_ = threadIdx.x; asm volatile("" : "+v"(tid_));
    const int tid = tid_, wid = __builtin_amdgcn_readfirstlane(tid >> 6), lane = tid & 63, wr = wid >> 2, wc = wid & 3, fr = lane & 15, fq = lane >> 4;
    const int K = g.K, nt = K / BK;
    unsigned voffA[2], voffB[2];
#pragma unroll
    for (int i = 0; i < 2; ++i) { int R, C; stage_rc(tid * 16 + i * 8192, R, C); const int Rb = Epi::PERM ? ((R & ~31) + perm32(R & 31)) : R;
        voffA[i] = (unsigned)(R * K + C) * 2u; voffB[i] = (unsigned)(Rb * K + C) * 2u; }
    const size_t kstep = (size_t)(BK * 2);
    const size_t hstep = (size_t)HALF * K * 2;
    const size_t tstep = 2 * hstep;
    const unsigned ldsw = (unsigned)wid * 1024u;
    const int aoff = lds_byte(wr * 64 + fr, fq * 8), boff = lds_byte(wc * 32 + fr, fq * 8);
#define PG8_SA(b, h) (((b) * 2 + (h)) * HTB)
#define PG8_SB(b, h) ((4 + (b) * 2 + (h)) * HTB)
#define PG8_STAGE(bufoff, gbase, voff) do { _Pragma("unroll") for (int _i = 0; _i < 2; ++_i) \
        __builtin_amdgcn_global_load_lds((const unsigned*)((const char*)(gbase) + (voff)[_i]), (PG8_LAS unsigned*)(lds + (bufoff) + ldsw + _i * 8192), 16, 0, 0); } while (0)
#define PG8_LDA(dst, b, h) do { _Pragma("unroll") for (int m = 0; m < 4; ++m) _Pragma("unroll") for (int k = 0; k < 2; ++k) dst[m][k] = *(const PG8_LAS bf16x8*)(lds + PG8_SA(b, h) + aoff + m * 2048 + k * 1024); } while (0)
#define PG8_LDB(dst, b, h) do { _Pragma("unroll") for (int n = 0; n < 2; ++n) _Pragma("unroll") for (int k = 0; k < 2; ++k) dst[n][k] = *(const PG8_LAS bf16x8*)(lds + PG8_SB(b, h) + boff + n * 2048 + k * 1024); } while (0)
#define PG8_MMA(ai, bj, At, Bt) do { __builtin_amdgcn_s_setprio(1); _Pragma("unroll") for (int m = 0; m < 4; ++m) _Pragma("unroll") for (int n = 0; n < 2; ++n) _Pragma("unroll") for (int k = 0; k < 2; ++k) \
        acc[ai][bj][m][n] = __builtin_amdgcn_mfma_f32_16x16x32_bf16(Bt[n][k], At[m][k], acc[ai][bj][m][n], 0, 0, 0); __builtin_amdgcn_s_setprio(0); } while (0)
#define PG8_WAIT_V(n) asm volatile("s_waitcnt vmcnt(" #n ")" ::: "memory")
#define PG8_WAIT_L(n) asm volatile("s_waitcnt lgkmcnt(" #n ")" ::: "memory")
#define PG8_BAR __builtin_amdgcn_s_barrier()
#define PG8_SCHED __builtin_amdgcn_sched_barrier(0)
    Unit cur, nxt; int ui = 0;
    if (!S.next(0, cur)) return;
    f32x4 acc[2][2][4][2];
#pragma unroll
    for (int a = 0; a < 2; ++a)
#pragma unroll
        for (int b = 0; b < 2; ++b)
#pragma unroll
            for (int m = 0; m < 4; ++m)
#pragma unroll
                for (int n = 0; n < 2; ++n) acc[a][b][m][n] = (f32x4){0.f, 0.f, 0.f, 0.f};
    bf16x8 At[4][2], B0[2][2], B1[2][2];
    const char* cA = (const char*)g.A + (size_t)cur.pm * tstep; const char* cB = (const char*)g.Bt + (size_t)cur.pn * tstep;
    S.a_ready(cur);
    if constexpr (SP2) {
        PG8_STAGE(PG8_SB(0, 0), cB, voffB); PG8_STAGE(PG8_SB(0, 1), cB + hstep, voffB); PG8_STAGE(PG8_SA(0, 0), cA, voffA); PG8_STAGE(PG8_SA(0, 1), cA + hstep, voffA);
        if (wr == 1) PG8_BAR;
        PG8_WAIT_V(2); PG8_BAR;
        PG8_STAGE(PG8_SB(1, 0), cB + kstep, voffB); PG8_STAGE(PG8_SA(1, 0), cA + kstep, voffA); PG8_STAGE(PG8_SB(1, 1), cB + hstep + kstep, voffB);
        PG8_WAIT_V(6); PG8_BAR;
    } else {
        PG8_STAGE(PG8_SB(0, 0), cB, voffB); PG8_STAGE(PG8_SA(0, 0), cA, voffA); PG8_STAGE(PG8_SB(0, 1), cB + hstep, voffB); PG8_STAGE(PG8_SA(0, 1), cA + hstep, voffA);
        if (wr == 1) PG8_BAR;
        PG8_WAIT_V(4); PG8_BAR;
        PG8_STAGE(PG8_SB(1, 0), cB + kstep, voffB); PG8_STAGE(PG8_SA(1, 0), cA + kstep, voffA); PG8_STAGE(PG8_SB(1, 1), cB + hstep + kstep, voffB);
        PG8_WAIT_V(6); PG8_BAR;
    }
    for (;;) {
        const bool has_next = S.next(ui + 1, nxt);
        const char* nA = has_next ? (const char*)g.A + (size_t)nxt.pm * tstep : cA; const char* nB = has_next ? (const char*)g.Bt + (size_t)nxt.pn * tstep : cB;
        for (int t = 0; t < nt; t += 2) {
            const bool last = (t == nt - 2);
            const char* a1 = cA + (size_t)(t + 1) * kstep;
            const char* a2 = last ? nA : cA + (size_t)(t + 2) * kstep; const char* b2 = last ? nB : cB + (size_t)(t + 2) * kstep;
            const char* a3 = a2 + kstep; const char* b3 = b2 + kstep;
            if (last && has_next) S.a_ready(nxt);
            if constexpr (SP2) {
            PG8_LDB(B0, 0, 0); PG8_LDB(B1, 0, 1); PG8_SCHED; PG8_LDA(At, 0, 0); PG8_STAGE(PG8_SA(1, 1), a1 + hstep, voffA);
            PG8_WAIT_V(8); PG8_WAIT_L(0); PG8_BAR; PG8_MMA(0, 0, At, B0); PG8_MMA(0, 1, At, B1); PG8_BAR; PG8_SCHED;
            PG8_LDA(At, 0, 1); PG8_STAGE(PG8_SB(0, 0), b2, voffB); PG8_STAGE(PG8_SB(0, 1), b2 + hstep, voffB); PG8_STAGE(PG8_SA(0, 0), a2, voffA);
            PG8_WAIT_V(8); PG8_WAIT_L(0); PG8_BAR; PG8_MMA(1, 0, At, B0); PG8_MMA(1, 1, At, B1); PG8_BAR; PG8_SCHED;
            PG8_LDB(B0, 1, 0); PG8_LDB(B1, 1, 1); PG8_SCHED; PG8_LDA(At, 1, 0); PG8_STAGE(PG8_SA(0, 1), a2 + hstep, voffA);
            PG8_WAIT_V(8); PG8_WAIT_L(0); PG8_BAR; PG8_MMA(0, 0, At, B0); PG8_MMA(0, 1, At, B1); PG8_BAR; PG8_SCHED;
            PG8_LDA(At, 1, 1); PG8_STAGE(PG8_SB(1, 0), b3, voffB); PG8_STAGE(PG8_SB(1, 1), b3 + hstep, voffB); PG8_STAGE(PG8_SA(1, 0), a3, voffA);
            PG8_WAIT_V(8); PG8_WAIT_L(0); PG8_BAR; PG8_MMA(1, 0, At, B0); PG8_MMA(1, 1, At, B1); PG8_BAR; PG8_SCHED;
            } else {
            PG8_LDB(B0, 0, 0); PG8_SCHED; PG8_LDA(At, 0, 0); PG8_STAGE(PG8_SA(1, 1), a1 + hstep, voffA);
            PG8_WAIT_L(8); PG8_BAR; PG8_WAIT_L(0); PG8_MMA(0, 0, At, B0); PG8_BAR; PG8_SCHED;
            PG8_LDB(B1, 0, 1); PG8_STAGE(PG8_SB(0, 0), b2, voffB);
            PG8_BAR; PG8_WAIT_L(0); PG8_MMA(0, 1, At, B1); PG8_BAR;
            PG8_LDA(At, 0, 1); PG8_STAGE(PG8_SA(0, 0), a2, voffA);
            PG8_BAR; PG8_WAIT_L(0); PG8_MMA(1, 0, At, B0); PG8_BAR; PG8_SCHED;
            PG8_STAGE(PG8_SB(0, 1), b2 + hstep, voffB);
            PG8_WAIT_V(6); PG8_BAR; PG8_MMA(1, 1, At, B1); PG8_BAR;
            PG8_LDB(B0, 1, 0); PG8_SCHED; PG8_LDA(At, 1, 0); PG8_STAGE(PG8_SA(0, 1), a2 + hstep, voffA);
            PG8_WAIT_L(8); PG8_BAR; PG8_WAIT_L(0); PG8_MMA(0, 0, At, B0); PG8_BAR; PG8_SCHED;
            PG8_LDB(B1, 1, 1); PG8_STAGE(PG8_SB(1, 0), b3, voffB);
            PG8_BAR; PG8_WAIT_L(0); PG8_MMA(0, 1, At, B1); PG8_BAR;
            PG8_LDA(At, 1, 1); PG8_STAGE(PG8_SA(1, 0), a3, voffA);
            PG8_BAR; PG8_WAIT_L(0); PG8_MMA(1, 0, At, B0); PG8_BAR; PG8_SCHED;
            PG8_STAGE(PG8_SB(1, 1), b3 + hstep, voffB);
            PG8_WAIT_V(6); PG8_BAR; PG8_MMA(1, 1, At, B1); PG8_BAR;
            }
        }
        if constexpr (ALIGN_EPI) { if (wr == 0) PG8_BAR; }
        if constexpr (!Epi::AFTER_DRAIN) { E(acc, cur, wr, wc, fr, fq); S.done(cur); }
        if (!has_next) break;
#pragma unroll
        for (int a = 0; a < 2; ++a)
#pragma unroll
            for (int b = 0; b < 2; ++b)
#pragma unroll
                for (int m = 0; m < 4; ++m)
#pragma unroll
                    for (int n = 0; n < 2; ++n) acc[a][b][m][n] = (f32x4){0.f, 0.f, 0.f, 0.f};
        cur = nxt; cA = nA; cB = nB; ++ui;
        if constexpr (ALIGN_EPI) { if (wr == 1) PG8_BAR; }
    }
    PG8_WAIT_V(0);
    if constexpr (!ALIGN_EPI) { if (wr == 0) PG8_BAR; }
    PG8_BAR;
    if constexpr (Epi::AFTER_DRAIN) { E.fused(acc, cur, wr, wc, fr, fq, lds, wid, lane); S.done(cur); }
#undef PG8_SA
#undef PG8_SB
#undef PG8_STAGE
#undef PG8_LDA
#undef PG8_LDB
#undef PG8_MMA
#undef PG8_WAIT_V
#undef PG8_WAIT_L
#undef PG8_BAR
#undef PG8_SCHED
}
}

#ifndef PG8_SP2
#define PG8_SP2 true
#endif
#ifndef PG8_ALIGN
#define PG8_ALIGN true
#endif
#ifndef MK_MODE
#define MK_MODE 2
#endif

constexpr int D = 1024, NB = 16, SEQ = 4096, DSEQ = 16, NPROJ = 3200, NPAD = 3328;
constexpr int MP = NB * SEQ;
constexpr int MS = NB * DSEQ;
constexpr int MT = MP + MS;
constexpr int NPHASE = 10;
constexpr float EPS = 1e-6f;
constexpr int ZC_P = 0, ZC_ZP = 256, ZC_GB = 512, ZC_GC = 896, ZC_HX = 1280, ZC_ZC = 1664, ZC_U = 2048, ZC_V = 2432, ZC_ZG = 2816;
constexpr size_t OFF_YP = 0, OFF_YS = (size_t)MP * D, OFF_POOL_P = OFF_YS + (size_t)MS * D, OFF_CONV_P = OFF_POOL_P + 2 * 16 * 15 * 256,
                 OFF_POOL_S = OFF_CONV_P + 2 * 16 * 2 * 384, OFF_CONV_S = OFF_POOL_S + 2 * 16 * 15 * 256, OFF_V_S = OFF_CONV_S + 2 * 16 * 2 * 384;
constexpr size_t MiB = 1u << 20;
constexpr size_t WS_CTL = 0, CTL_ZERO_BYTES = 32768;
constexpr size_t WS_MOD = 1 * MiB;
constexpr size_t WS_WST = 2 * MiB;
constexpr size_t WS_WPT = 3 * MiB;
constexpr size_t WS_WOUT = 4 * MiB;
constexpr size_t WS_WIN = 8 * MiB;
constexpr size_t WIN_BYTES = (size_t)NPAD * D * 2;
constexpr size_t WS_H = 32 * MiB;
constexpr size_t WS_YC = 161 * MiB;
constexpr size_t WS_Z = 290 * MiB;
constexpr size_t WS_END = WS_Z + (size_t)MT * NPAD * 2;
static_assert(WS_WIN + 2 * WIN_BYTES <= WS_H && WS_H + (size_t)MT * D * 2 <= WS_YC && WS_YC + (size_t)MT * D * 2 <= WS_Z && WS_END <= 1024 * MiB, "d_ws map");

constexpr int NWAVES = 8;
constexpr int LDS_BYTES = 147456;

#define GAS __attribute__((address_space(1)))
#define CAS __attribute__((address_space(4)))
#define LAS __attribute__((address_space(3)))
typedef unsigned short bf16;
typedef unsigned v4u __attribute__((ext_vector_type(4)));
typedef unsigned v2u __attribute__((ext_vector_type(2)));
typedef float f32x4 __attribute__((ext_vector_type(4)));
typedef short bf16x8 __attribute__((ext_vector_type(8)));
#define LDS_WAIT() asm volatile("s_waitcnt lgkmcnt(0)" ::: "memory")

__device__ __forceinline__ unsigned f2bf(float f) { unsigned u = __builtin_bit_cast(unsigned, f); return (u + 0x7fffu + ((u >> 16) & 1u)) >> 16; }
__device__ __forceinline__ unsigned pk2(float lo, float hi) { return f2bf(lo) | (f2bf(hi) << 16); }
__device__ __forceinline__ float bf2f(unsigned v) { return __builtin_bit_cast(float, v << 16); }
__device__ __forceinline__ float silu_f(float x) { return x / (1.0f + __expf(-x)); }
__device__ __forceinline__ void unpack8(const v4u p, float (&f)[8]) {
    f[0] = __builtin_bit_cast(float, p.x << 16); f[1] = __builtin_bit_cast(float, p.x & 0xffff0000u);
    f[2] = __builtin_bit_cast(float, p.y << 16); f[3] = __builtin_bit_cast(float, p.y & 0xffff0000u);
    f[4] = __builtin_bit_cast(float, p.z << 16); f[5] = __builtin_bit_cast(float, p.z & 0xffff0000u);
    f[6] = __builtin_bit_cast(float, p.w << 16); f[7] = __builtin_bit_cast(float, p.w & 0xffff0000u); }
__device__ __forceinline__ v4u pack8(const float (&f)[8]) { v4u r; r.x = pk2(f[0], f[1]); r.y = pk2(f[2], f[3]); r.z = pk2(f[4], f[5]); r.w = pk2(f[6], f[7]); return r; }
__device__ __forceinline__ float wave_sum(float v) {
#pragma unroll
    for (int o = 1; o < 64; o <<= 1) v += __shfl_xor(v, o);
    return v;
}

struct Frame {
    LAS unsigned char* lds;
    int tid, lane, wave, vcu, G;
    const float *x_prompt, *x_sample, *state_pool, *state_conv, *c_prompt, *c_sample, *norm_g, *w_ada, *b_ada, *w_in, *w_pool, *pool_scale, *w_conv, *v_norm_g, *v_norm_b, *w_s, *b_s, *w_out, *final_g;
    float* out;
    float* mod; bf16 *WST, *WPT, *WOUT, *WIN, *H, *YC, *Z;
};

typedef GAS unsigned gu32;
#define RLX_AGENT __ATOMIC_RELAXED, __HIP_MEMORY_SCOPE_AGENT
constexpr int CW_BAR = 1024;
constexpr int MISC_OFF = 143360;
#define XB_TMO      128
#define XB_XCNT(j)  (256  + 64 * (j))
#define XB_XSUB(j)  (1280 + 64 * (j))
#define XB_XGEN(j)  (2304 + 64 * (j))
#define XB_TOP      3328
#define XB_TOPGEN   3392
#define XCD_BAR_WORDS 3456
#define XB_SPIN_CAP (1u << 18)

__device__ __forceinline__ unsigned xb_ld(unsigned* p)              { return __hip_atomic_load(p, __ATOMIC_RELAXED, __HIP_MEMORY_SCOPE_AGENT); }
__device__ __forceinline__ unsigned xb_add(unsigned* p, unsigned v) { return __hip_atomic_fetch_add(p, v, __ATOMIC_RELAXED, __HIP_MEMORY_SCOPE_AGENT); }
__device__ __forceinline__ unsigned xb_xcc_id() { return (unsigned)__builtin_amdgcn_s_getreg((3 << 11) | 20) & 0xFu; }
#define XB_SPIN(cond, bar) do { unsigned _sp = 0; while (cond) { __builtin_amdgcn_s_sleep(1); \
    if ((++_sp & 255u) == 0u) { if (xb_ld(&(bar)[XB_TMO])) break; if (_sp > XB_SPIN_CAP) { atomicAdd(&(bar)[XB_TMO], 1u); break; } } } } while (0)

struct XcdBarrier {
    unsigned* bar; unsigned x;
    volatile LAS unsigned* st;
};

__device__ __forceinline__ XcdBarrier xcd_barrier_post(unsigned* bar, volatile LAS unsigned* st) {
    XcdBarrier b; b.bar = bar; b.x = xb_xcc_id(); b.st = st;
    if (threadIdx.x == 0) (void)xb_add(&bar[XB_XCNT(b.x)], 1u);
    return b;
}
__device__ __forceinline__ void xcd_barrier_complete(unsigned* bar, unsigned x, unsigned& nloc, unsigned& nx) {
    const unsigned G = gridDim.x * gridDim.y * gridDim.z;
    unsigned sum, cnt, mine, sp = 0u;
    for (;;) {
        sum = 0u; cnt = 0u; mine = 0u;
#pragma unroll
        for (unsigned j = 0; j < 16; ++j) { const unsigned c = xb_ld(&bar[XB_XCNT(j)]); sum += c; cnt += (c > 0u) ? 1u : 0u; mine = (j == x) ? c : mine; }
        if (sum == G) break;
        __builtin_amdgcn_s_sleep(1);
        if ((++sp & 255u) == 0u) { if (xb_ld(&bar[XB_TMO])) break; if (sp > XB_SPIN_CAP) { atomicAdd(&bar[XB_TMO], 1u); break; } }
    }
    nloc = mine > 0u ? mine : 1u; nx = cnt > 0u ? cnt : 1u;
}

__device__ __forceinline__ void xcd_barrier(const XcdBarrier& b) {
    asm volatile("s_waitcnt vmcnt(0)" ::: "memory");
    __syncthreads();
    if (threadIdx.x == 0) {
        unsigned* bar = b.bar;
        __builtin_amdgcn_s_waitcnt(0);
        unsigned nloc = b.st[0], nx = b.st[1];
        if (nloc == 0u) { xcd_barrier_complete(bar, b.x, nloc, nx); b.st[0] = nloc; b.st[1] = nx; }
        const unsigned old = xb_add(&bar[XB_XSUB(b.x)], 1u);
        const unsigned gen = old / nloc;
        if (old + 1u == (gen + 1u) * nloc) {
            __builtin_amdgcn_fence(__ATOMIC_RELEASE, "agent");
            asm volatile("s_waitcnt vmcnt(0)" ::: "memory");
            const unsigned og = xb_add(&bar[XB_TOP], 1u);
            const unsigned tg = og / nx;
            if (og + 1u == (tg + 1u) * nx) xb_add(&bar[XB_TOPGEN], 1u);
            else XB_SPIN(xb_ld(&bar[XB_TOPGEN]) == tg, bar);
            __builtin_amdgcn_fence(__ATOMIC_ACQUIRE, "agent");
            xb_add(&bar[XB_XGEN(b.x)], 1u);
            asm volatile("s_waitcnt vmcnt(0)" ::: "memory");
        } else {
            XB_SPIN(xb_ld(&bar[XB_XGEN(b.x)]) == gen, bar);
            __builtin_amdgcn_fence(__ATOMIC_ACQUIRE, "agent");
            asm volatile("s_waitcnt vmcnt(0)" ::: "memory");
        }
    }
    __syncthreads();
}

__device__ __forceinline__ void p0_transpose_item(const float* W, int K, int N, bf16* WT, LAS float* scr, int item, int lane) {
    const int nblk = N / 32, kb = item / nblk, nb = item % nblk, k0 = 64 * kb, n0 = 32 * nb;
#pragma unroll 8
    for (int i = 0; i < 32; ++i) { const int kk = 2 * i + (lane >> 5); scr[kk * 33 + (lane & 31)] = W[(size_t)(k0 + kk) * N + n0 + (lane & 31)]; }
    LDS_WAIT(); asm volatile("" ::: "memory");
    const int c = lane & 7;
#pragma unroll
    for (int j = 0; j < 4; ++j) { const int n = (lane >> 3) + 8 * j; const LAS float* s = scr + (8 * c) * 33 + n;
        v4u o; o.x = pk2(s[0 * 33], s[1 * 33]); o.y = pk2(s[2 * 33], s[3 * 33]); o.z = pk2(s[4 * 33], s[5 * 33]); o.w = pk2(s[6 * 33], s[7 * 33]);
        *(GAS v4u*)(WT + (size_t)(n0 + n) * K + k0 + 8 * c) = o; }
    LDS_WAIT(); asm volatile("" ::: "memory");
}
__device__ __forceinline__ void p0_mod_item(const Frame& F, int item) {
    const int l = item / 48, cb = item % 48;
    LAS float* S = (LAS float*)F.lds;
    for (int idx = F.tid; idx < 32 * 1024; idx += 512) { const int r = idx & 31, k = idx >> 5;
        const float cv = r < 16 ? F.c_prompt[r * 1024 + k] : F.c_sample[(r - 16) * 1024 + k]; S[idx] = silu_f(cv); }
    __syncthreads();
    float acc[32];
#pragma unroll
    for (int r = 0; r < 32; ++r) acc[r] = 0.f;
    const float* wp = F.w_ada + (size_t)l * 1024 * 3072 + cb * 64 + F.lane;
#pragma unroll 2
    for (int kk = 0; kk < 128; ++kk) { const int k = F.wave * 128 + kk; const float wv = wp[(size_t)k * 3072];
        const LAS f32x4* sp = (const LAS f32x4*)(S + k * 32);
#pragma unroll
        for (int q = 0; q < 8; ++q) { const f32x4 s = sp[q]; acc[4 * q + 0] += s.x * wv; acc[4 * q + 1] += s.y * wv; acc[4 * q + 2] += s.z * wv; acc[4 * q + 3] += s.w * wv; } }
    __syncthreads();
    LAS float* red = (LAS float*)F.lds;
#pragma unroll
    for (int r = 0; r < 32; ++r) red[(F.wave * 32 + r) * 64 + F.lane] = acc[r];
    __syncthreads();
    for (int o = F.tid; o < 2048; o += 512) { const int r = o >> 6, ln = o & 63; float s = 0.f;
#pragma unroll
        for (int w = 0; w < 8; ++w) s += red[(w * 32 + r) * 64 + ln];
        F.mod[((size_t)l * 32 + r) * 3072 + cb * 64 + ln] = s + F.b_ada[l * 3072 + cb * 64 + ln]; }
    __syncthreads();
}
__device__ __forceinline__ void p0_prologue(const Frame& F) {
    for (int it = F.vcu; it < 96; it += F.G) p0_mod_item(F, it);
    LAS float* scr = (LAS float*)(F.lds + F.wave * 16384);
    const int gw = F.vcu * NWAVES + F.wave, NGW = F.G * NWAVES;
    constexpr int I_IN = (D / 64) * (NPROJ / 32), I_OUT = (D / 64) * (D / 32);
    for (int it = gw; it < 2 * I_IN + 2 * I_OUT; it += NGW) {
        int r = it;
        if (r < 2 * I_IN) { const int l = r / I_IN; r -= l * I_IN; p0_transpose_item(F.w_in + (size_t)l * D * NPROJ, D, NPROJ, F.WIN + (size_t)l * NPAD * D, scr, r, F.lane); }
        else { r -= 2 * I_IN; const int l = r / I_OUT; r -= l * I_OUT; p0_transpose_item(F.w_out + (size_t)l * D * D, D, D, F.WOUT + (size_t)l * D * D, scr, r, F.lane); }
    }
    const int gt = F.vcu * 512 + F.tid, NGT = F.G * 512;
    for (int i = gt; i < 2 * (NPAD - NPROJ) * D / 8; i += NGT) {
        const int l = i / ((NPAD - NPROJ) * D / 8), j = i % ((NPAD - NPROJ) * D / 8);
        *(GAS v4u*)(F.WIN + (size_t)l * NPAD * D + (size_t)NPROJ * D + (size_t)j * 8) = (v4u){0u, 0u, 0u, 0u}; }
    for (int i = gt; i < 2 * 6 * 128 * 128; i += NGT) {
        const int s = i & 127, t = (i >> 7) & 127; F.WST[i] = (bf16)(((s >> 6) <= (t >> 6)) ? f2bf(F.w_s[i]) : 0u); }
    for (int i = gt; i < 2 * 4 * 64 * 64; i += NGT) {
        const int d = i & 63, e = (i >> 6) & 63, lg = i >> 12; F.WPT[i] = (bf16)f2bf(F.w_pool[(lg * 64 + d) * 64 + e]); }
}

__device__ __forceinline__ void norm_phase(const Frame& F, int l) {
    const int gw = F.vcu * NWAVES + F.wave, NGW = F.G * NWAVES;
    const float* modl = F.mod + (size_t)l * 32 * 3072; const float* ng = F.norm_g + l * 1024;
    for (int row = gw; row < MT; row += NGW) {
        const float* xr; int r;
        if (row < MP) { xr = (l == 0 ? F.x_prompt : F.out) + (size_t)row * D; r = row >> 12; }
        else { xr = (l == 0 ? F.x_sample + (size_t)(row - MP) * D : F.out + (size_t)row * D); r = 16 + ((row - MP) >> 4); }
        const GAS f32x4* xp = (const GAS f32x4*)xr + F.lane;
        f32x4 v[4]; float ss = 0.f;
#pragma unroll
        for (int j = 0; j < 4; ++j) { v[j] = xp[64 * j]; ss += (v[j].x * v[j].x + v[j].y * v[j].y) + (v[j].z * v[j].z + v[j].w * v[j].w); }
        const float rstd = 1.0f / sqrtf(wave_sum(ss) * (1.0f / D) + EPS);
        const float* mr = modl + (size_t)r * 3072;
        GAS v2u* o8 = (GAS v2u*)(F.H + (size_t)row * D) + F.lane;
#pragma unroll
        for (int j = 0; j < 4; ++j) { const int col = 4 * F.lane + 256 * j;
            const f32x4 g = *(const f32x4*)(ng + col), sh = *(const f32x4*)(mr + col), sc = *(const f32x4*)(mr + 1024 + col);
            const f32x4 y = (v[j] * rstd * g) * (sc + 1.0f) + sh;
            v2u w; w.x = pk2(y.x, y.y); w.y = pk2(y.z, y.w); o8[64 * j] = w; }
    }
}
__device__ __forceinline__ void final_norm_phase(const Frame& F) {
    const int gw = F.vcu * NWAVES + F.wave, NGW = F.G * NWAVES;
    for (int row = gw; row < MT; row += NGW) {
        GAS f32x4* xp = (GAS f32x4*)(F.out + (size_t)row * D) + F.lane;
        f32x4 v[4]; float ss = 0.f;
#pragma unroll
        for (int j = 0; j < 4; ++j) { v[j] = xp[64 * j]; ss += (v[j].x * v[j].x + v[j].y * v[j].y) + (v[j].z * v[j].z + v[j].w * v[j].w); }
        const float rstd = 1.0f / sqrtf(wave_sum(ss) * (1.0f / D) + EPS);
#pragma unroll
        for (int j = 0; j < 4; ++j) { const f32x4 g = *(const f32x4*)(F.final_g + 4 * F.lane + 256 * j); xp[64 * j] = v[j] * rstd * g; }
    }
}

constexpr int PB_OFF = 0, DM_OFF = 73728, DM_PITCH = 528, VN_PITCH = 272;
__device__ __forceinline__ void mixer_tile(const Frame& F, int l, int ti) {
    const bool samp = ti >= 512;
    const int b = samp ? ti - 512 : ti >> 5, c = samp ? 0 : ti & 31;
    const int nTok = samp ? 16 : 128;
    const size_t row0 = samp ? (size_t)MP + b * 16 : (size_t)b * SEQ + c * 128;
    const int pos0 = samp ? 1024 : c * 128;
    const bf16* Zt = F.Z + row0 * NPAD;
    bf16* Yt = F.YC + row0 * D;
    LAS bf16* pbuf = (LAS bf16*)(F.lds + PB_OFF);
    LAS unsigned char* dmat = F.lds + DM_OFF;
    const int fr = F.lane & 15, fq = F.lane >> 4;
    for (int idx = F.tid; idx < (15 + nTok) * 32; idx += 512) {
        const int r = idx >> 5, ch8 = (idx & 31) * 8, t = r - 15;
        v4u val = (v4u){0u, 0u, 0u, 0u};
        if (t >= 0 || (!samp && c > 0)) val = *(const GAS v4u*)(Zt + (ptrdiff_t)t * NPAD + ZC_P + ch8);
        else if (samp) { const float* sp = F.state_pool + ((size_t)(l * 16 + b) * 15 + r) * 256 + ch8; const f32x4 a = *(const f32x4*)sp, bb = *(const f32x4*)(sp + 4);
            val.x = pk2(a.x, a.y); val.y = pk2(a.z, a.w); val.z = pk2(bb.x, bb.y); val.w = pk2(bb.z, bb.w); }
        *(LAS v4u*)(pbuf + r * 256 + ch8) = val;
    }
    __syncthreads();
    {
        const int ch = F.tid & 255, seg = F.tid >> 8, g = ch >> 6, w = 2 << g;
        const int t0 = seg * 64, len = samp ? (seg == 0 ? 16 : 0) : 64;
        if (len > 0) {
            float S = 0.f;
            for (int i = 1; i < w; ++i) S += bf2f(pbuf[(15 + t0 - i) * 256 + ch]);
            for (int t = t0; t < t0 + len; ++t) {
                const float pv = bf2f(pbuf[(15 + t) * 256 + ch]);
                S += pv;
                const int pc = pos0 + t + 1; const float cnt = (float)(pc < w ? pc : w);
                const float dv = S / cnt - pv;
                *(LAS bf16*)(dmat + t * DM_PITCH + ch * 2) = (bf16)f2bf(dv);
                S -= bf2f(pbuf[(15 + t - w + 1) * 256 + ch]);
            }
        }
    }
    __syncthreads();
    if (F.wave * 16 < nTok) {
        const int t = F.wave * 16 + fr;
        const bf16* zr = Zt + (size_t)t * NPAD; bf16* yr = Yt + (size_t)t * D;
        const bf16* WpT = F.WPT + l * 16384; const float* ps = F.pool_scale + l * 256;
#pragma unroll 1
        for (int g = 0; g < 4; ++g) {
            bf16x8 bfr[2];
#pragma unroll
            for (int kk = 0; kk < 2; ++kk) bfr[kk] = *(const LAS bf16x8*)(dmat + t * DM_PITCH + (g * 64 + 32 * kk + 8 * fq) * 2);
            f32x4 acc[4];
#pragma unroll
            for (int et = 0; et < 4; ++et) { const int e = 32 * (et >> 1) + 8 * (fr >> 2) + 4 * (et & 1) + (fr & 3);
                acc[et] = (f32x4){0.f, 0.f, 0.f, 0.f};
#pragma unroll
                for (int kk = 0; kk < 2; ++kk) { const bf16x8 a = *(const GAS bf16x8*)(WpT + (g * 64 + e) * 64 + 32 * kk + 8 * fq);
                    acc[et] = __builtin_amdgcn_mfma_f32_16x16x32_bf16(a, bfr[kk], acc[et], 0, 0, 0); } }
#pragma unroll
            for (int hh = 0; hh < 2; ++hh) { const int ch = g * 64 + 32 * hh + 8 * fq;
                const v4u zp = *(const GAS v4u*)(zr + ZC_ZP + ch); const f32x4 s0 = *(const f32x4*)(ps + ch), s1 = *(const f32x4*)(ps + ch + 4);
                float zv[8], o[8]; unpack8(zp, zv);
#pragma unroll
                for (int i = 0; i < 4; ++i) { o[i] = acc[2 * hh][i] * s0[i] * silu_f(zv[i]); o[4 + i] = acc[2 * hh + 1][i] * s1[i] * silu_f(zv[4 + i]); }
                *(GAS v4u*)(yr + ch) = pack8(o); }
        }
    }
    if (samp || c == 31) {
        float* dst = F.out + (samp ? OFF_POOL_S : OFF_POOL_P) + (size_t)(l * 16 + b) * 15 * 256;
        const int rbase = samp ? 16 : 128;
        for (int idx = F.tid; idx < 15 * 256; idx += 512) dst[idx] = bf2f(pbuf[rbase * 256 + idx]);
    }
    __syncthreads();
    LAS unsigned char* vnT = F.lds;
    {
        float gm[6], be[6];
#pragma unroll
        for (int j = 0; j < 3; ++j) { const int cc = 2 * F.lane + 128 * j; gm[2 * j] = F.v_norm_g[l * 384 + cc]; gm[2 * j + 1] = F.v_norm_g[l * 384 + cc + 1]; be[2 * j] = F.v_norm_b[l * 384 + cc]; be[2 * j + 1] = F.v_norm_b[l * 384 + cc + 1]; }
        if (samp) for (int idx = F.tid; idx < 768; idx += 512) *(LAS v4u*)(vnT + (idx >> 1) * VN_PITCH + 32 + (idx & 1) * 16) = (v4u){0u, 0u, 0u, 0u};
        for (int tt = F.wave; tt < nTok; tt += 8) {
            const bf16* vr = Zt + (size_t)tt * NPAD + ZC_V + 2 * F.lane;
            float x[6]; float s = 0.f;
#pragma unroll
            for (int j = 0; j < 3; ++j) { const unsigned wv = *(const GAS unsigned*)(vr + 128 * j); x[2 * j] = __builtin_bit_cast(float, wv << 16); x[2 * j + 1] = __builtin_bit_cast(float, wv & 0xffff0000u); s += x[2 * j] + x[2 * j + 1]; }
            const float mu = wave_sum(s) * (1.0f / 384.0f); float q = 0.f;
#pragma unroll
            for (int i = 0; i < 6; ++i) { x[i] -= mu; q += x[i] * x[i]; }
            const float rstd = 1.0f / sqrtf(wave_sum(q) * (1.0f / 384.0f) + EPS);
#pragma unroll
            for (int j = 0; j < 3; ++j)
#pragma unroll
                for (int e = 0; e < 2; ++e) { const int cc = 2 * F.lane + 128 * j + e; const float y = x[2 * j + e] * rstd * gm[2 * j + e] + be[2 * j + e];
                    *(LAS bf16*)(vnT + cc * VN_PITCH + tt * 2) = (bf16)f2bf(y);
                    if (samp) F.out[OFF_V_S + ((size_t)(l * 16 + b) * 16 + tt) * 384 + cc] = y; }
        }
    }
    __syncthreads();
    if (F.wave * 16 < nTok) {
        const int t = F.wave * 16 + fr; const int nk = samp ? 1 : 4;
        const bf16* zr = Zt + (size_t)t * NPAD; bf16* yr = Yt + (size_t)t * D;
        const bf16* Wl = F.WST + (size_t)l * 6 * 16384;
#pragma unroll 1
        for (int h = 0; h < 6; ++h) {
            bf16x8 bfr[4];
#pragma unroll
            for (int kk = 0; kk < 4; ++kk) bfr[kk] = (kk < nk) ? *(const GAS bf16x8*)(Wl + (size_t)(h * 128 + t) * 128 + 32 * kk + 8 * fq) : (bf16x8){0, 0, 0, 0, 0, 0, 0, 0};
            f32x4 acc[4];
#pragma unroll
            for (int ct = 0; ct < 4; ++ct) { const int chrow = h * 64 + 32 * (ct >> 1) + 8 * (fr >> 2) + 4 * (ct & 1) + (fr & 3);
                acc[ct] = (f32x4){0.f, 0.f, 0.f, 0.f};
#pragma unroll
                for (int kk = 0; kk < 4; ++kk) if (kk < nk) { const bf16x8 a = *(const LAS bf16x8*)(vnT + chrow * VN_PITCH + (32 * kk + 8 * fq) * 2);
                    acc[ct] = __builtin_amdgcn_mfma_f32_16x16x32_bf16(a, bfr[kk], acc[ct], 0, 0, 0); } }
            const float bsv = F.b_s[(l * 6 + h) * 128 + t];
#pragma unroll
            for (int hh = 0; hh < 2; ++hh) { const int ch = h * 64 + 32 * hh + 8 * fq;
                const v4u up = *(const GAS v4u*)(zr + ZC_U + ch), zg = *(const GAS v4u*)(zr + ZC_ZG + ch);
                float uv[8], zv[8], o[8]; unpack8(up, uv); unpack8(zg, zv);
#pragma unroll
                for (int i = 0; i < 4; ++i) { o[i] = uv[i] * (acc[2 * hh][i] + bsv) * silu_f(zv[i]); o[4 + i] = uv[4 + i] * (acc[2 * hh + 1][i] + bsv) * silu_f(zv[4 + i]); }
                *(GAS v4u*)(yr + 640 + ch) = pack8(o); }
        }
    }
    if (F.tid < 384) {
        const int chunk = F.tid % 48, seg = F.tid / 48, ch = chunk * 8, t0 = seg * 16;
        if (t0 < nTok) {
            float w0[8], w1[8], w2[8], q2[8], q1[8];
            const float* wc = F.w_conv + l * 3 * 384 + ch;
#pragma unroll
            for (int i = 0; i < 8; ++i) { w0[i] = wc[i]; w1[i] = wc[384 + i]; w2[i] = wc[768 + i]; }
#pragma unroll
            for (int hrow = 0; hrow < 2; ++hrow) {
                const int t = t0 - 2 + hrow; float qq[8];
                if (t >= 0 || (!samp && c > 0)) { const bf16* zr = Zt + (ptrdiff_t)t * NPAD; float a[8], bq[8];
                    unpack8(*(const GAS v4u*)(zr + ZC_GC + ch), a); unpack8(*(const GAS v4u*)(zr + ZC_HX + ch), bq);
#pragma unroll
                    for (int i = 0; i < 8; ++i) qq[i] = a[i] * bq[i]; }
                else if (samp) { const float* sp = F.state_conv + ((size_t)(l * 16 + b) * 2 + (2 + t)) * 384 + ch;
#pragma unroll
                    for (int i = 0; i < 8; ++i) qq[i] = sp[i]; }
                else {
#pragma unroll
                    for (int i = 0; i < 8; ++i) qq[i] = 0.f; }
#pragma unroll
                for (int i = 0; i < 8; ++i) { if (hrow == 0) q2[i] = qq[i]; else q1[i] = qq[i]; }
            }
            float* cdst = F.out + (samp ? OFF_CONV_S : OFF_CONV_P) + (size_t)(l * 16 + b) * 2 * 384 + ch;
            const bool wstate = samp || (c == 31 && t0 == 112);
            for (int t = t0; t < t0 + 16; ++t) {
                const bf16* zr = Zt + (size_t)t * NPAD; float gb[8], gc[8], hx[8], zc[8], o[8], q0[8];
                unpack8(*(const GAS v4u*)(zr + ZC_GB + ch), gb); unpack8(*(const GAS v4u*)(zr + ZC_GC + ch), gc);
                unpack8(*(const GAS v4u*)(zr + ZC_HX + ch), hx); unpack8(*(const GAS v4u*)(zr + ZC_ZC + ch), zc);
#pragma unroll
                for (int i = 0; i < 8; ++i) { q0[i] = gc[i] * hx[i]; o[i] = gb[i] * (w0[i] * q2[i] + w1[i] * q1[i] + w2[i] * q0[i]) * silu_f(zc[i]); }
                *(GAS v4u*)(Yt + (size_t)t * D + 256 + ch) = pack8(o);
                if (wstate && t >= t0 + 14) {
#pragma unroll
                    for (int i = 0; i < 8; ++i) cdst[(t - (t0 + 14)) * 384 + i] = q0[i]; }
#pragma unroll
                for (int i = 0; i < 8; ++i) { q2[i] = q1[i]; q1[i] = q0[i]; }
            }
        }
    }
    __syncthreads();
}
__device__ __forceinline__ void mixer_phase(const Frame& F, int l) {
    for (int ti = F.vcu; ti < 512 + 16; ti += F.G) mixer_tile(F, l, ti);
}

struct Args { const float* in[19]; float* out; unsigned char* ws; int ph_lo, ph_hi; };
__global__ void __launch_bounds__(NWAVES * 64, 2) fwd(Args args) {
    extern __shared__ __attribute__((aligned(16))) unsigned char lds_raw[];
    const int lo = args.ph_lo, hi = args.ph_hi;
#define MAKE_FRAME() Frame F; { int tid_ = threadIdx.x; asm volatile("" : "+v"(tid_)); const CAS Args* ap = (const CAS Args*)__builtin_amdgcn_kernarg_segment_ptr(); asm volatile("" : "+s"(ap)); \
    F.lds = (LAS unsigned char*)lds_raw; F.tid = tid_; F.lane = F.tid & 63; F.wave = __builtin_amdgcn_readfirstlane(F.tid >> 6); \
    F.G = gridDim.x; { const int bx = blockIdx.x; F.vcu = (F.G % 8 == 0) ? (bx % 8) * (F.G / 8) + bx / 8 : bx; } \
    F.x_prompt = ap->in[0]; F.x_sample = ap->in[1]; F.state_pool = ap->in[2]; F.state_conv = ap->in[3]; F.c_prompt = ap->in[4]; F.c_sample = ap->in[5]; \
    F.norm_g = ap->in[6]; F.w_ada = ap->in[7]; F.b_ada = ap->in[8]; F.w_in = ap->in[9]; F.w_pool = ap->in[10]; F.pool_scale = ap->in[11]; F.w_conv = ap->in[12]; \
    F.v_norm_g = ap->in[13]; F.v_norm_b = ap->in[14]; F.w_s = ap->in[15]; F.b_s = ap->in[16]; F.w_out = ap->in[17]; F.final_g = ap->in[18]; \
    F.out = ap->out; unsigned char* ws = ap->ws; \
    F.mod = (float*)(ws + WS_MOD); F.WST = (bf16*)(ws + WS_WST); F.WPT = (bf16*)(ws + WS_WPT); F.WOUT = (bf16*)(ws + WS_WOUT); F.WIN = (bf16*)(ws + WS_WIN); \
    F.H = (bf16*)(ws + WS_H); F.YC = (bf16*)(ws + WS_YC); F.Z = (bf16*)(ws + WS_Z); }
#if MK_MODE == 1
    cg::grid_group grid = cg::this_grid();
#define GRID_BAR() grid.sync()
#elif MK_MODE == 2
    if (threadIdx.x < 2) ((LAS unsigned*)(lds_raw + MISC_OFF))[threadIdx.x] = 0u;
    __syncthreads();
    if (hi - lo > 1) { const CAS Args* ap0 = (const CAS Args*)__builtin_amdgcn_kernarg_segment_ptr(); (void)xcd_barrier_post((unsigned*)(ap0->ws + WS_CTL) + CW_BAR, (volatile LAS unsigned*)(lds_raw + MISC_OFF)); }
#define GRID_BAR() do { const CAS Args* apb = (const CAS Args*)__builtin_amdgcn_kernarg_segment_ptr(); asm volatile("" : "+s"(apb)); XcdBarrier xb_; xb_.bar = (unsigned*)(apb->ws + WS_CTL) + CW_BAR; xb_.x = xb_xcc_id(); \
    xb_.st = (volatile LAS unsigned*)(lds_raw + MISC_OFF); xcd_barrier(xb_); } while (0)
#else
#define GRID_BAR() do {} while (0)
#endif
#define IN(k) (lo <= (k) && (k) < hi)
#define SEAM(k) do { if (IN(k) && IN((k) + 1)) GRID_BAR(); } while (0)

    if (IN(0)) { MAKE_FRAME(); p0_prologue(F); SEAM(0); }
#pragma unroll 1
    for (int l = 0; l < 2; ++l) {
        const int pb = 1 + 4 * l;
        if (IN(pb)) { MAKE_FRAME(); norm_phase(F, l); SEAM(pb); }
        if (IN(pb + 1)) {
            MAKE_FRAME(); pg8::Gemm g{F.H, F.WIN + (size_t)l * NPAD * D, MT, NPAD, D}; pg8::StaticOrder S; S.init(MT, NPAD, F.G, (int)blockIdx.x);
            pg8::EpiZ E{F.Z, NPAD};
            pg8::gemm_phase<pg8::EpiZ, pg8::StaticOrder, PG8_ALIGN, PG8_SP2>(F.lds, g, S, E);
            SEAM(pb + 1);
        }
        if (IN(pb + 2)) { MAKE_FRAME(); mixer_phase(F, l); SEAM(pb + 2); }
        if (IN(pb + 3)) {
            MAKE_FRAME(); pg8::Gemm g{F.YC, F.WOUT + (size_t)l * D * D, MT, D, D}; pg8::StaticOrder S; S.init(MT, D, F.G, (int)blockIdx.x);
            pg8::EpiRes E{l == 0 ? F.x_prompt : F.out, l == 0 ? F.x_sample : F.out + (size_t)MP * D, F.out, F.mod + (size_t)l * 32 * 3072 + 2048, MP};
            pg8::gemm_phase<pg8::EpiRes, pg8::StaticOrder, PG8_ALIGN, PG8_SP2>(F.lds, g, S, E);
            SEAM(pb + 3);
        }
    }
    if (IN(9)) { MAKE_FRAME(); final_norm_phase(F); }
#undef IN
#undef SEAM
}

extern "C" void kernel_launch(void* const* d_in, const int* in_sizes, int n_in, void* d_out, int out_size, void* d_ws, size_t ws_size, hipStream_t stream) {
    static int grid = 0;
    if (grid == 0) {
        if (n_in != 19 || ws_size < WS_END) { fprintf(stderr, "kernel_launch: expected 19 inputs and >= %zu bytes of workspace; got n_in %d, ws %zu\n", (size_t)WS_END, n_in, ws_size); grid = -1; return; }
        int dev = 0, cus = 0, per_cu = 0;
        if (hipGetDevice(&dev) != hipSuccess || hipDeviceGetAttribute(&cus, hipDeviceAttributeMultiprocessorCount, dev) != hipSuccess) { grid = -1; return; }
        if (hipFuncSetAttribute((const void*)fwd, hipFuncAttributeMaxDynamicSharedMemorySize, LDS_BYTES) != hipSuccess) { fprintf(stderr, "kernel_launch: hipFuncSetAttribute failed\n"); grid = -1; return; }
        if (hipOccupancyMaxActiveBlocksPerMultiprocessor(&per_cu, (const void*)fwd, NWAVES * 64, LDS_BYTES) != hipSuccess || per_cu < 1) { fprintf(stderr, "kernel_launch: occupancy query says %d blocks per CU\n", per_cu); (void)hipGetLastError(); per_cu = 1; }
        grid = cus;
    }
    if (grid < 0) return;
    (void)hipMemsetAsync((char*)d_ws + WS_CTL, 0, CTL_ZERO_BYTES, stream);
    Args a{};
    for (int i = 0; i < 19; ++i) a.in[i] = (const float*)d_in[i];
    a.out = (float*)d_out; a.ws = (unsigned char*)d_ws;
#if MK_MODE == 2
    a.ph_lo = 0; a.ph_hi = NPHASE;
    hipLaunchKernelGGL(fwd, dim3(grid), dim3(NWAVES * 64), LDS_BYTES, stream, a);
    { const hipError_t le = hipPeekAtLastError(); if (le != hipSuccess) fprintf(stderr, "kernel_launch: launch failed: %s\n", hipGetErrorName(le)); }
#elif MK_MODE == 0
    for (int ph = 0; ph < NPHASE; ++ph) { a.ph_lo = ph; a.ph_hi = ph + 1; hipLaunchKernelGGL(fwd, dim3(grid), dim3(NWAVES * 64), LDS_BYTES, stream, a);
        const hipError_t le = hipPeekAtLastError(); if (le != hipSuccess) { fprintf(stderr, "kernel_launch: launch %d failed: %s\n", ph, hipGetErrorName(le)); break; } }
#else
    a.ph_lo = 0; a.ph_hi = NPHASE;
    void* kargs[] = {&a};
    const hipError_t le = hipLaunchCooperativeKernel((const void*)fwd, dim3(grid), dim3(NWAVES * 64), kargs, LDS_BYTES, stream);
    if (le != hipSuccess) fprintf(stderr, "kernel_launch: cooperative launch failed: %s (grid %d)\n", hipGetErrorName(le), grid);
#endif
}
```

```cpp
#include <hip/hip_runtime.h>
#include <hip/hip_cooperative_groups.h>
#include <cstdio>
#include <cstdint>
#include <cstddef>
namespace cg = cooperative_groups;
#ifndef TELEM
#define TELEM 0
#endif
#define TEL_WORD_OFF 16384
#if TELEM
#define TEL_DECL unsigned long long tel_t0_ = 0ull
#ifndef TEL_WG
#define TEL_WG 0
#endif
#define TEL_ON(id, leader) ((TELEM) == (id) && blockIdx.x == TEL_WG && (leader))
#define TEL_START(id, leader) do { if (TEL_ON(id, leader)) tel_t0_ = ((id) & 1) ? (unsigned long long)__builtin_amdgcn_s_memrealtime() : (unsigned long long)__builtin_readcyclecounter(); } while (0)
#define TEL_STOP(id, leader, telp) do { if (TEL_ON(id, leader)) { const unsigned long long t1_ = ((id) & 1) ? (unsigned long long)__builtin_amdgcn_s_memrealtime() : (unsigned long long)__builtin_readcyclecounter(); \
    __hip_atomic_fetch_add((unsigned long long*)(telp), t1_ - tel_t0_, __ATOMIC_RELAXED, __HIP_MEMORY_SCOPE_AGENT); } } while (0)
#else
#define TEL_DECL
#define TEL_START(id, leader) do {} while (0)
#define TEL_STOP(id, leader, telp) do {} while (0)
#endif
#ifndef PROBE_EPI2
#define PROBE_EPI2 0
#endif
namespace pg8 {
#define PG8_LAS __attribute__((address_space(3)))
typedef unsigned short bf16_t;
typedef short bf16x8 __attribute__((ext_vector_type(8)));
typedef float f32x4 __attribute__((ext_vector_type(4)));
typedef unsigned u32x4 __attribute__((ext_vector_type(4)));
constexpr int BM = 256, BK = 64, HALF = 128, HTB = HALF * BK * 2  , STAGE_BYTES = 8 * HTB, NXCD = 8, WGM = 8;

__host__ __device__ __forceinline__ int lds_byte(int r, int c) { const int st = (r >> 4) * 2 + (c >> 5), rr = r & 15, cc = c & 31, ob = rr * 64 + cc * 2; return st * 1024 + (ob ^ (((ob >> 9) & 1) << 5)); }
__host__ __device__ __forceinline__ void stage_rc(int b, int& R, int& C) { const int st = b / 1024, sb = b % 1024, swz = sb ^ (((sb >> 9) & 1) << 5); R = (st >> 1) * 16 + swz / 64; C = (st & 1) * 32 + (swz % 64) / 2; }
__host__ __device__ __forceinline__ int perm32(int rho) { const int n = rho >> 4, i = rho & 15; return 8 * (i >> 2) + 4 * n + (i & 3); }

struct Unit { int pm, pn; };
struct Gemm { const bf16_t* A; const bf16_t* Bt; int M, N, K; };

struct StaticOrder {
    int nM, nN, nwg, G, c;
    __host__ __device__ void init(int M, int N, int G_, int c_) { nM = M / BM; nN = N / BM; nwg = nM * nN; G = G_; c = c_; }
    __host__ __device__ bool next(int i, Unit& u) const {
        const long L = (long)i * G + c; if (L >= nwg) return false;
        int wgid = (int)L; { const int q = nwg / NXCD, r = nwg % NXCD, xcd = wgid % NXCD, off = wgid / NXCD; wgid = (xcd < r ? xcd * (q + 1) : r * (q + 1) + (xcd - r) * q) + off; }
        const int nig = WGM * nN, gid = wgid / nig, fm = gid * WGM, gsz = (nM - fm) < WGM ? (nM - fm) : WGM;
        u.pm = fm + ((wgid % nig) % gsz); u.pn = (wgid % nig) / gsz; return true;
    }
    __device__ __forceinline__ void a_ready(const Unit&) const {}
    __device__ __forceinline__ void done(const Unit&) const {}
};


__device__ __forceinline__ unsigned cvt_pk_bf16(float lo, float hi) { unsigned r; asm volatile("v_cvt_pk_bf16_f32 %0, %1, %2" : "=v"(r) : "v"(lo), "v"(hi)); return r; }

struct EpiZ {
    static constexpr bool PERM = true, AFTER_DRAIN = false; static constexpr int TEL_ID = 1;
    bf16_t* O; int ldc;
    __device__ __forceinline__ bool probe_twice() const { return PROBE_EPI2 == 1; }
    __device__ __forceinline__ void operator()(const f32x4 (&acc)[2][2][4][2], const Unit& u, int wr, int wc, int fr, int fq) const {
        const int row0 = u.pm * BM + wr * 64 + fr, col0 = u.pn * BM + wc * 32 + 8 * fq;
#pragma unroll
        for (int ai = 0; ai < 2; ++ai)
#pragma unroll
            for (int m = 0; m < 4; ++m) { bf16_t* rowp = O + (size_t)(row0 + ai * HALF + m * 16) * ldc + col0;
#pragma unroll
                for (int bj = 0; bj < 2; ++bj) { const f32x4 v0 = acc[ai][bj][m][0], v1 = acc[ai][bj][m][1];
                    u32x4 w; w.x = cvt_pk_bf16(v0[0], v0[1]); w.y = cvt_pk_bf16(v0[2], v0[3]); w.z = cvt_pk_bf16(v1[0], v1[1]); w.w = cvt_pk_bf16(v1[2], v1[3]);
                    *(u32x4*)(rowp + bj * HALF) = w; } }
    }
};
struct EpiRes {
    static constexpr bool PERM = false, AFTER_DRAIN = false; static constexpr int TEL_ID = 3;
    const float* base; float* out; const float* gate;
    __device__ __forceinline__ bool probe_twice() const { return PROBE_EPI2 == 2 && base != out; }
    __device__ __forceinline__ void operator()(const f32x4 (&acc)[2][2][4][2], const Unit& u, int wr, int wc, int fr, int fq) const {
        const int col0 = u.pn * BM + wc * 32 + 4 * fq;
        const float* gp = gate + (size_t)(u.pm >> 4) * 3072 + col0;
        f32x4 gv[2][2];
#pragma unroll
        for (int bj = 0; bj < 2; ++bj)
#pragma unroll
            for (int n = 0; n < 2; ++n) gv[bj][n] = *(const f32x4*)(gp + bj * HALF + n * 16);
#pragma unroll
        for (int ai = 0; ai < 2; ++ai) {
            const size_t off = (size_t)(u.pm * BM + ai * HALF + wr * 64 + fr) * 1024 + col0;
            f32x4 bv[4][2][2];
#pragma unroll
            for (int m = 0; m < 4; ++m)
#pragma unroll
                for (int bj = 0; bj < 2; ++bj)
#pragma unroll
                    for (int n = 0; n < 2; ++n) bv[m][bj][n] = *(const f32x4*)(base + off + (size_t)m * 16 * 1024 + bj * HALF + n * 16);
#pragma unroll
            for (int m = 0; m < 4; ++m)
#pragma unroll
                for (int bj = 0; bj < 2; ++bj)
#pragma unroll
                    for (int n = 0; n < 2; ++n) *(f32x4*)(out + off + (size_t)m * 16 * 1024 + bj * HALF + n * 16) = bv[m][bj][n] + gv[bj][n] * acc[ai][bj][m][n];
            asm volatile("" ::: "memory"); }
    }
};

template <class Epi, class Sched, bool ALIGN_EPI = false, bool SP2 = false>
__device__ __forceinline__ void gemm_phase(PG8_LAS unsigned char* lds, const Gemm g, const Sched& S, const Epi& E, unsigned char* telp = nullptr) {
    TEL_DECL;
    int tid_ = threadIdx.x; asm volatile("" : "+v"(tid_));
    const int tid = tid_, wid = __builtin_amdgcn_readfirstlane(tid >> 6), lane = tid & 63, wr = wid >> 2, wc = wid & 3, fr = lane & 15, fq = lane >> 4;
    const int K = g.K, nt = K / BK;
    unsigned voffA[2], voffB[2];
#pragma unroll
    for (int i = 0; i < 2; ++i) { int R, C; stage_rc(tid * 16 + i * 8192, R, C); const int Rb = Epi::PERM ? ((R & ~31) + perm32(R & 31)) : R;
        voffA[i] = (unsigned)(R * K + C) * 2u; voffB[i] = (unsigned)(Rb * K + C) * 2u; }
    const size_t kstep = (size_t)(BK * 2);
    const size_t hstep = (size_t)HALF * K * 2;
    const size_t tstep = 2 * hstep;
    const unsigned ldsw = (unsigned)wid * 1024u;
    const int aoff = lds_byte(wr * 64 + fr, fq * 8), boff = lds_byte(wc * 32 + fr, fq * 8);
#define PG8_SA(b, h) (((b) * 2 + (h)) * HTB)
#define PG8_SB(b, h) ((4 + (b) * 2 + (h)) * HTB)
#define PG8_STAGE(bufoff, gbase, voff) do { _Pragma("unroll") for (int _i = 0; _i < 2; ++_i) \
        __builtin_amdgcn_global_load_lds((const unsigned*)((const char*)(gbase) + (voff)[_i]), (PG8_LAS unsigned*)(lds + (bufoff) + ldsw + _i * 8192), 16, 0, 0); } while (0)
#define PG8_LDA(dst, b, h) do { _Pragma("unroll") for (int m = 0; m < 4; ++m) _Pragma("unroll") for (int k = 0; k < 2; ++k) dst[m][k] = *(const PG8_LAS bf16x8*)(lds + PG8_SA(b, h) + aoff + m * 2048 + k * 1024); } while (0)
#define PG8_LDB(dst, b, h) do { _Pragma("unroll") for (int n = 0; n < 2; ++n) _Pragma("unroll") for (int k = 0; k < 2; ++k) dst[n][k] = *(const PG8_LAS bf16x8*)(lds + PG8_SB(b, h) + boff + n * 2048 + k * 1024); } while (0)
#define PG8_MMA(ai, bj, At, Bt) do { __builtin_amdgcn_s_setprio(1); _Pragma("unroll") for (int m = 0; m < 4; ++m) _Pragma("unroll") for (int n = 0; n < 2; ++n) _Pragma("unroll") for (int k = 0; k < 2; ++k) \
        acc[ai][bj][m][n] = __builtin_amdgcn_mfma_f32_16x16x32_bf16(Bt[n][k], At[m][k], acc[ai][bj][m][n], 0, 0, 0); __builtin_amdgcn_s_setprio(0); } while (0)
#define PG8_WAIT_V(n) asm volatile("s_waitcnt vmcnt(" #n ")" ::: "memory")
#define PG8_WAIT_L(n) asm volatile("s_waitcnt lgkmcnt(" #n ")" ::: "memory")
#define PG8_BAR __builtin_amdgcn_s_barrier()
#define PG8_SCHED __builtin_amdgcn_sched_barrier(0)
    Unit cur, nxt; int ui = 0;
    if (!S.next(0, cur)) return;
    f32x4 acc[2][2][4][2];
#pragma unroll
    for (int a = 0; a < 2; ++a)
#pragma unroll
        for (int b = 0; b < 2; ++b)
#pragma unroll
            for (int m = 0; m < 4; ++m)
#pragma unroll
                for (int n = 0; n < 2; ++n) acc[a][b][m][n] = (f32x4){0.f, 0.f, 0.f, 0.f};
    bf16x8 At[4][2], B0[2][2], B1[2][2];
    const char* cA = (const char*)g.A + (size_t)cur.pm * tstep; const char* cB = (const char*)g.Bt + (size_t)cur.pn * tstep;
    S.a_ready(cur);
    if constexpr (SP2) {
        PG8_STAGE(PG8_SB(0, 0), cB, voffB); PG8_STAGE(PG8_SB(0, 1), cB + hstep, voffB); PG8_STAGE(PG8_SA(0, 0), cA, voffA); PG8_STAGE(PG8_SA(0, 1), cA + hstep, voffA);
        if (wr == 1) PG8_BAR;
        PG8_WAIT_V(2); PG8_BAR;
        PG8_STAGE(PG8_SB(1, 0), cB + kstep, voffB); PG8_STAGE(PG8_SA(1, 0), cA + kstep, voffA); PG8_STAGE(PG8_SB(1, 1), cB + hstep + kstep, voffB);
        PG8_WAIT_V(6); PG8_BAR;
    } else {
        PG8_STAGE(PG8_SB(0, 0), cB, voffB); PG8_STAGE(PG8_SA(0, 0), cA, voffA); PG8_STAGE(PG8_SB(0, 1), cB + hstep, voffB); PG8_STAGE(PG8_SA(0, 1), cA + hstep, voffA);
        if (wr == 1) PG8_BAR;
        PG8_WAIT_V(4); PG8_BAR;
        PG8_STAGE(PG8_SB(1, 0), cB + kstep, voffB); PG8_STAGE(PG8_SA(1, 0), cA + kstep, voffA); PG8_STAGE(PG8_SB(1, 1), cB + hstep + kstep, voffB);
        PG8_WAIT_V(6); PG8_BAR;
    }
    for (;;) {
        const bool has_next = S.next(ui + 1, nxt);
        const char* nA = has_next ? (const char*)g.A + (size_t)nxt.pm * tstep : cA; const char* nB = has_next ? (const char*)g.Bt + (size_t)nxt.pn * tstep : cB;
        TEL_START(Epi::TEL_ID, tid == 0); TEL_START(Epi::TEL_ID + 1, tid == 0);
        for (int t = 0; t < nt; t += 2) {
            const bool last = (t == nt - 2);
            const char* a1 = cA + (size_t)(t + 1) * kstep;
            const char* a2 = last ? nA : cA + (size_t)(t + 2) * kstep; const char* b2 = last ? nB : cB + (size_t)(t + 2) * kstep;
            const char* a3 = a2 + kstep; const char* b3 = b2 + kstep;
            if (last && has_next) S.a_ready(nxt);
            if constexpr (SP2) {
            PG8_LDB(B0, 0, 0); PG8_LDB(B1, 0, 1); PG8_SCHED; PG8_LDA(At, 0, 0); PG8_STAGE(PG8_SA(1, 1), a1 + hstep, voffA);
            PG8_WAIT_V(8); PG8_WAIT_L(0); PG8_BAR; PG8_MMA(0, 0, At, B0); PG8_MMA(0, 1, At, B1); PG8_BAR; PG8_SCHED;
            PG8_LDA(At, 0, 1); PG8_STAGE(PG8_SB(0, 0), b2, voffB); PG8_STAGE(PG8_SB(0, 1), b2 + hstep, voffB); PG8_STAGE(PG8_SA(0, 0), a2, voffA);
            PG8_WAIT_V(8); PG8_WAIT_L(0); PG8_BAR; PG8_MMA(1, 0, At, B0); PG8_MMA(1, 1, At, B1); PG8_BAR; PG8_SCHED;
            PG8_LDB(B0, 1, 0); PG8_LDB(B1, 1, 1); PG8_SCHED; PG8_LDA(At, 1, 0); PG8_STAGE(PG8_SA(0, 1), a2 + hstep, voffA);
            PG8_WAIT_V(8); PG8_WAIT_L(0); PG8_BAR; PG8_MMA(0, 0, At, B0); PG8_MMA(0, 1, At, B1); PG8_BAR; PG8_SCHED;
            PG8_LDA(At, 1, 1); PG8_STAGE(PG8_SB(1, 0), b3, voffB); PG8_STAGE(PG8_SB(1, 1), b3 + hstep, voffB); PG8_STAGE(PG8_SA(1, 0), a3, voffA);
            PG8_WAIT_V(8); PG8_WAIT_L(0); PG8_BAR; PG8_MMA(1, 0, At, B0); PG8_MMA(1, 1, At, B1); PG8_BAR; PG8_SCHED;
            } else {
            PG8_LDB(B0, 0, 0); PG8_SCHED; PG8_LDA(At, 0, 0); PG8_STAGE(PG8_SA(1, 1), a1 + hstep, voffA);
            PG8_WAIT_L(8); PG8_BAR; PG8_WAIT_L(0); PG8_MMA(0, 0, At, B0); PG8_BAR; PG8_SCHED;
            PG8_LDB(B1, 0, 1); PG8_STAGE(PG8_SB(0, 0), b2, voffB);
            PG8_BAR; PG8_WAIT_L(0); PG8_MMA(0, 1, At, B1); PG8_BAR;
            PG8_LDA(At, 0, 1); PG8_STAGE(PG8_SA(0, 0), a2, voffA);
            PG8_BAR; PG8_WAIT_L(0); PG8_MMA(1, 0, At, B0); PG8_BAR; PG8_SCHED;
            PG8_STAGE(PG8_SB(0, 1), b2 + hstep, voffB);
            PG8_WAIT_V(6); PG8_BAR; PG8_MMA(1, 1, At, B1); PG8_BAR;
            PG8_LDB(B0, 1, 0); PG8_SCHED; PG8_LDA(At, 1, 0); PG8_STAGE(PG8_SA(0, 1), a2 + hstep, voffA);
            PG8_WAIT_L(8); PG8_BAR; PG8_WAIT_L(0); PG8_MMA(0, 0, At, B0); PG8_BAR; PG8_SCHED;
            PG8_LDB(B1, 1, 1); PG8_STAGE(PG8_SB(1, 0), b3, voffB);
            PG8_BAR; PG8_WAIT_L(0); PG8_MMA(0, 1, At, B1); PG8_BAR;
            PG8_LDA(At, 1, 1); PG8_STAGE(PG8_SA(1, 0), a3, voffA);
            PG8_BAR; PG8_WAIT_L(0); PG8_MMA(1, 0, At, B0); PG8_BAR; PG8_SCHED;
            PG8_STAGE(PG8_SB(1, 1), b3 + hstep, voffB);
            PG8_WAIT_V(6); PG8_BAR; PG8_MMA(1, 1, At, B1); PG8_BAR;
            }
        }
        TEL_STOP(Epi::TEL_ID, tid == 0, telp); TEL_STOP(Epi::TEL_ID + 1, tid == 0, telp);
        if constexpr (ALIGN_EPI) { if (wr == 0) PG8_BAR; }
        if constexpr (!Epi::AFTER_DRAIN) { E(acc, cur, wr, wc, fr, fq);
#if defined(PROBE_EPI2)
            if (E.probe_twice()) { asm volatile("" ::: "memory"); E(acc, cur, wr, wc, fr, fq); }
#endif
            S.done(cur); }
        if (!has_next) break;
#pragma unroll
        for (int a = 0; a < 2; ++a)
#pragma unroll
            for (int b = 0; b < 2; ++b)
#pragma unroll
                for (int m = 0; m < 4; ++m)
#pragma unroll
                    for (int n = 0; n < 2; ++n) acc[a][b][m][n] = (f32x4){0.f, 0.f, 0.f, 0.f};
        cur = nxt; cA = nA; cB = nB; ++ui;
        if constexpr (ALIGN_EPI) { if (wr == 1) PG8_BAR; }
    }
    PG8_WAIT_V(0);
    if constexpr (!ALIGN_EPI) { if (wr == 0) PG8_BAR; }
    PG8_BAR;
    if constexpr (Epi::AFTER_DRAIN) { E.fused(acc, cur, wr, wc, fr, fq, lds, wid, lane); S.done(cur); }
#undef PG8_SA
#undef PG8_SB
#undef PG8_STAGE
#undef PG8_LDA
#undef PG8_LDB
#undef PG8_MMA
#undef PG8_WAIT_V
#undef PG8_WAIT_L
#undef PG8_BAR
#undef PG8_SCHED
}
}

#ifndef PG8_SP2
#define PG8_SP2 true
#endif
#ifndef PG8_ALIGN
#define PG8_ALIGN true
#endif
#ifndef REP_MASK
#define REP_MASK 0
#endif
#ifndef MK_MODE
#define MK_MODE 2
#endif

constexpr int D = 1024, NB = 16, SEQ = 4096, DSEQ = 16, NPROJ = 3200, NPAD = 3328;
constexpr int MP = NB * SEQ;
constexpr int MS = NB * DSEQ;
constexpr int MT = MP + MS;
constexpr int NPHASE = 10;
constexpr float EPS = 1e-6f;
constexpr int ZC_P = 0, ZC_ZP = 256, ZC_GB = 512, ZC_GC = 896, ZC_HX = 1280, ZC_ZC = 1664, ZC_U = 2048, ZC_V = 2432, ZC_ZG = 2816;
constexpr size_t OFF_YP = 0, OFF_YS = (size_t)MP * D, OFF_POOL_P = OFF_YS + (size_t)MS * D, OFF_CONV_P = OFF_POOL_P + 2 * 16 * 15 * 256,
                 OFF_POOL_S = OFF_CONV_P + 2 * 16 * 2 * 384, OFF_CONV_S = OFF_POOL_S + 2 * 16 * 15 * 256, OFF_V_S = OFF_CONV_S + 2 * 16 * 2 * 384;
constexpr size_t MiB = 1u << 20;
constexpr size_t WS_CTL = 0, CTL_ZERO_BYTES = 32768;
constexpr size_t WS_MOD = 1 * MiB;
constexpr size_t WS_WST = 2 * MiB;
constexpr size_t WS_WPT = 3 * MiB;
constexpr size_t WS_WOUT = 4 * MiB;
constexpr size_t WS_WIN = 8 * MiB;
constexpr size_t WIN_BYTES = (size_t)NPAD * D * 2;
constexpr size_t WS_H = 32 * MiB;
constexpr size_t WS_YC = 161 * MiB;
constexpr size_t WS_Z = 290 * MiB;
constexpr size_t WS_END = WS_Z + (size_t)MT * NPAD * 2;
static_assert(WS_WIN + 2 * WIN_BYTES <= WS_H && WS_H + (size_t)MT * D * 2 <= WS_YC && WS_YC + (size_t)MT * D * 2 <= WS_Z && WS_END <= 1024 * MiB, "d_ws map");

constexpr int NWAVES = 8;
constexpr int LDS_BYTES = 147456;

#define GAS __attribute__((address_space(1)))
#define CAS __attribute__((address_space(4)))
#define LAS __attribute__((address_space(3)))
typedef unsigned short bf16;
typedef unsigned v4u __attribute__((ext_vector_type(4)));
typedef unsigned v2u __attribute__((ext_vector_type(2)));
typedef float f32x4 __attribute__((ext_vector_type(4)));
typedef short bf16x8 __attribute__((ext_vector_type(8)));
#define LDS_WAIT() asm volatile("s_waitcnt lgkmcnt(0)" ::: "memory")

__device__ __forceinline__ unsigned f2bf(float f) { unsigned u = __builtin_bit_cast(unsigned, f); return (u + 0x7fffu + ((u >> 16) & 1u)) >> 16; }
__device__ __forceinline__ unsigned pk2(float lo, float hi) { return f2bf(lo) | (f2bf(hi) << 16); }
__device__ __forceinline__ float bf2f(unsigned v) { return __builtin_bit_cast(float, v << 16); }
__device__ __forceinline__ float silu_f(float x) { return x / (1.0f + __expf(-x)); }
__device__ __forceinline__ void unpack8(const v4u p, float (&f)[8]) {
    f[0] = __builtin_bit_cast(float, p.x << 16); f[1] = __builtin_bit_cast(float, p.x & 0xffff0000u);
    f[2] = __builtin_bit_cast(float, p.y << 16); f[3] = __builtin_bit_cast(float, p.y & 0xffff0000u);
    f[4] = __builtin_bit_cast(float, p.z << 16); f[5] = __builtin_bit_cast(float, p.z & 0xffff0000u);
    f[6] = __builtin_bit_cast(float, p.w << 16); f[7] = __builtin_bit_cast(float, p.w & 0xffff0000u); }
__device__ __forceinline__ v4u pack8(const float (&f)[8]) { v4u r; r.x = pk2(f[0], f[1]); r.y = pk2(f[2], f[3]); r.z = pk2(f[4], f[5]); r.w = pk2(f[6], f[7]); return r; }
__device__ __forceinline__ float wave_sum(float v) {
#pragma unroll
    for (int o = 1; o < 64; o <<= 1) v += __shfl_xor(v, o);
    return v;
}

struct Frame {
    LAS unsigned char* lds;
    int tid, lane, wave, vcu, G;
    const float *x_prompt, *x_sample, *state_pool, *state_conv, *c_prompt, *c_sample, *norm_g, *w_ada, *b_ada, *w_in, *w_pool, *pool_scale, *w_conv, *v_norm_g, *v_norm_b, *w_s, *b_s, *w_out, *final_g;
    float* out;
    float* mod; bf16 *WST, *WPT, *WOUT, *WIN, *H, *YC, *Z;
};

typedef GAS unsigned gu32;
#define RLX_AGENT __ATOMIC_RELAXED, __HIP_MEMORY_SCOPE_AGENT
constexpr int CW_BAR = 1024;
constexpr int MISC_OFF = 143360;
#define XB_TMO      128
#define XB_XCNT(j)  (256  + 64 * (j))
#define XB_XSUB(j)  (1280 + 64 * (j))
#define XB_XGEN(j)  (2304 + 64 * (j))
#define XB_TOP      3328
#define XB_TOPGEN   3392
#define XCD_BAR_WORDS 3456
#define XB_SPIN_CAP (1u << 18)

__device__ __forceinline__ unsigned xb_ld(unsigned* p)              { return __hip_atomic_load(p, __ATOMIC_RELAXED, __HIP_MEMORY_SCOPE_AGENT); }
__device__ __forceinline__ unsigned xb_add(unsigned* p, unsigned v) { return __hip_atomic_fetch_add(p, v, __ATOMIC_RELAXED, __HIP_MEMORY_SCOPE_AGENT); }
__device__ __forceinline__ unsigned xb_xcc_id() { return (unsigned)__builtin_amdgcn_s_getreg((3 << 11) | 20) & 0xFu; }
#define XB_SPIN(cond, bar) do { unsigned _sp = 0; while (cond) { __builtin_amdgcn_s_sleep(1); \
    if ((++_sp & 255u) == 0u) { if (xb_ld(&(bar)[XB_TMO])) break; if (_sp > XB_SPIN_CAP) { atomicAdd(&(bar)[XB_TMO], 1u); break; } } } } while (0)

struct XcdBarrier {
    unsigned* bar; unsigned x;
    volatile LAS unsigned* st;
};

__device__ __forceinline__ XcdBarrier xcd_barrier_post(unsigned* bar, volatile LAS unsigned* st) {
    XcdBarrier b; b.bar = bar; b.x = xb_xcc_id(); b.st = st;
    if (threadIdx.x == 0) (void)xb_add(&bar[XB_XCNT(b.x)], 1u);
    return b;
}
__device__ __forceinline__ void xcd_barrier_complete(unsigned* bar, unsigned x, unsigned& nloc, unsigned& nx) {
    const unsigned G = gridDim.x * gridDim.y * gridDim.z;
    unsigned sum, cnt, mine, sp = 0u;
    for (;;) {
        sum = 0u; cnt = 0u; mine = 0u;
#pragma unroll
        for (unsigned j = 0; j < 16; ++j) { const unsigned c = xb_ld(&bar[XB_XCNT(j)]); sum += c; cnt += (c > 0u) ? 1u : 0u; mine = (j == x) ? c : mine; }
        if (sum == G) break;
        __builtin_amdgcn_s_sleep(1);
        if ((++sp & 255u) == 0u) { if (xb_ld(&bar[XB_TMO])) break; if (sp > XB_SPIN_CAP) { atomicAdd(&bar[XB_TMO], 1u); break; } }
    }
    nloc = mine > 0u ? mine : 1u; nx = cnt > 0u ? cnt : 1u;
}

__device__ __forceinline__ void xcd_barrier(const XcdBarrier& b) {
    asm volatile("s_waitcnt vmcnt(0)" ::: "memory");
    __syncthreads();
    if (threadIdx.x == 0) {
        unsigned* bar = b.bar;
        __builtin_amdgcn_s_waitcnt(0);
        unsigned nloc = b.st[0], nx = b.st[1];
        if (nloc == 0u) { xcd_barrier_complete(bar, b.x, nloc, nx); b.st[0] = nloc; b.st[1] = nx; }
        const unsigned old = xb_add(&bar[XB_XSUB(b.x)], 1u);
        const unsigned gen = old / nloc;
        if (old + 1u == (gen + 1u) * nloc) {
            __builtin_amdgcn_fence(__ATOMIC_RELEASE, "agent");
            asm volatile("s_waitcnt vmcnt(0)" ::: "memory");
            const unsigned og = xb_add(&bar[XB_TOP], 1u);
            const unsigned tg = og / nx;
            if (og + 1u == (tg + 1u) * nx) xb_add(&bar[XB_TOPGEN], 1u);
            else XB_SPIN(xb_ld(&bar[XB_TOPGEN]) == tg, bar);
            __builtin_amdgcn_fence(__ATOMIC_ACQUIRE, "agent");
            xb_add(&bar[XB_XGEN(b.x)], 1u);
            asm volatile("s_waitcnt vmcnt(0)" ::: "memory");
        } else {
            XB_SPIN(xb_ld(&bar[XB_XGEN(b.x)]) == gen, bar);
            __builtin_amdgcn_fence(__ATOMIC_ACQUIRE, "agent");
            asm volatile("s_waitcnt vmcnt(0)" ::: "memory");
        }
    }
    __syncthreads();
}

__device__ __forceinline__ void p0_transpose_item(const float* W, int K, int N, bf16* WT, LAS float* scr, int item, int lane) {
    const int nblk = N / 32, kb = item / nblk, nb = item % nblk, k0 = 64 * kb, n0 = 32 * nb;
#pragma unroll 8
    for (int i = 0; i < 32; ++i) { const int kk = 2 * i + (lane >> 5); scr[kk * 33 + (lane & 31)] = W[(size_t)(k0 + kk) * N + n0 + (lane & 31)]; }
    LDS_WAIT(); asm volatile("" ::: "memory");
    const int c = lane & 7;
#pragma unroll
    for (int j = 0; j < 4; ++j) { const int n = (lane >> 3) + 8 * j; const LAS float* s = scr + (8 * c) * 33 + n;
        v4u o; o.x = pk2(s[0 * 33], s[1 * 33]); o.y = pk2(s[2 * 33], s[3 * 33]); o.z = pk2(s[4 * 33], s[5 * 33]); o.w = pk2(s[6 * 33], s[7 * 33]);
        *(GAS v4u*)(WT + (size_t)(n0 + n) * K + k0 + 8 * c) = o; }
    LDS_WAIT(); asm volatile("" ::: "memory");
}
__device__ __forceinline__ void p0_mod_item(const Frame& F, int item) {
    const int l = item / 48, cb = item % 48;
    LAS float* S = (LAS float*)F.lds;
    for (int idx = F.tid; idx < 32 * 1024; idx += 512) { const int r = idx & 31, k = idx >> 5;
        const float cv = r < 16 ? F.c_prompt[r * 1024 + k] : F.c_sample[(r - 16) * 1024 + k]; S[idx] = silu_f(cv); }
    __syncthreads();
    float acc[32];
#pragma unroll
    for (int r = 0; r < 32; ++r) acc[r] = 0.f;
    const float* wp = F.w_ada + (size_t)l * 1024 * 3072 + cb * 64 + F.lane;
#pragma unroll 2
    for (int kk = 0; kk < 128; ++kk) { const int k = F.wave * 128 + kk; const float wv = wp[(size_t)k * 3072];
        const LAS f32x4* sp = (const LAS f32x4*)(S + k * 32);
#pragma unroll
        for (int q = 0; q < 8; ++q) { const f32x4 s = sp[q]; acc[4 * q + 0] += s.x * wv; acc[4 * q + 1] += s.y * wv; acc[4 * q + 2] += s.z * wv; acc[4 * q + 3] += s.w * wv; } }
    __syncthreads();
    LAS float* red = (LAS float*)F.lds;
#pragma unroll
    for (int r = 0; r < 32; ++r) red[(F.wave * 32 + r) * 64 + F.lane] = acc[r];
    __syncthreads();
    for (int o = F.tid; o < 2048; o += 512) { const int r = o >> 6, ln = o & 63; float s = 0.f;
#pragma unroll
        for (int w = 0; w < 8; ++w) s += red[(w * 32 + r) * 64 + ln];
        F.mod[((size_t)l * 32 + r) * 3072 + cb * 64 + ln] = s + F.b_ada[l * 3072 + cb * 64 + ln]; }
    __syncthreads();
}
__device__ __forceinline__ void p0_prologue(const Frame& F) {
    for (int it = F.vcu; it < 96; it += F.G) p0_mod_item(F, it);
    LAS float* scr = (LAS float*)(F.lds + F.wave * 16384);
    const int gw = F.vcu * NWAVES + F.wave, NGW = F.G * NWAVES;
    constexpr int I_IN = (D / 64) * (NPROJ / 32), I_OUT = (D / 64) * (D / 32);
    for (int it = gw; it < 2 * I_IN + 2 * I_OUT; it += NGW) {
        int r = it;
        if (r < 2 * I_IN) { const int l = r / I_IN; r -= l * I_IN; p0_transpose_item(F.w_in + (size_t)l * D * NPROJ, D, NPROJ, F.WIN + (size_t)l * NPAD * D, scr, r, F.lane); }
        else { r -= 2 * I_IN; const int l = r / I_OUT; r -= l * I_OUT; p0_transpose_item(F.w_out + (size_t)l * D * D, D, D, F.WOUT + (size_t)l * D * D, scr, r, F.lane); }
    }
    const int gt = F.vcu * 512 + F.tid, NGT = F.G * 512;
    for (int i = gt; i < 2 * (NPAD - NPROJ) * D / 8; i += NGT) {
        const int l = i / ((NPAD - NPROJ) * D / 8), j = i % ((NPAD - NPROJ) * D / 8);
        *(GAS v4u*)(F.WIN + (size_t)l * NPAD * D + (size_t)NPROJ * D + (size_t)j * 8) = (v4u){0u, 0u, 0u, 0u}; }
    for (int i = gt; i < 2 * 6 * 128 * 128; i += NGT) {
        const int s = i & 127, t = (i >> 7) & 127; F.WST[i] = (bf16)(((s >> 6) <= (t >> 6)) ? f2bf(F.w_s[i]) : 0u); }
    for (int i = gt; i < 2 * 4 * 64 * 64; i += NGT) {
        const int d = i & 63, e = (i >> 6) & 63, lg = i >> 12; F.WPT[i] = (bf16)f2bf(F.w_pool[(lg * 64 + d) * 64 + e]); }
}

__device__ __forceinline__ void norm_phase(const Frame& F, int l) {
    const int gw = F.vcu * NWAVES + F.wave, NGW = F.G * NWAVES;
    const float* modl = F.mod + (size_t)l * 32 * 3072; const float* ng = F.norm_g + l * 1024;
    for (int row = gw; row < MT; row += NGW) {
        const float* xr; int r;
        if (row < MP) { xr = (l == 0 ? F.x_prompt : F.out) + (size_t)row * D; r = row >> 12; }
        else { xr = (l == 0 ? F.x_sample + (size_t)(row - MP) * D : F.out + (size_t)row * D); r = 16 + ((row - MP) >> 4); }
        const GAS f32x4* xp = (const GAS f32x4*)xr + F.lane;
        f32x4 v[4]; float ss = 0.f;
#pragma unroll
        for (int j = 0; j < 4; ++j) { v[j] = xp[64 * j]; ss += (v[j].x * v[j].x + v[j].y * v[j].y) + (v[j].z * v[j].z + v[j].w * v[j].w); }
        const float rstd = 1.0f / sqrtf(wave_sum(ss) * (1.0f / D) + EPS);
        const float* mr = modl + (size_t)r * 3072;
        GAS v2u* o8 = (GAS v2u*)(F.H + (size_t)row * D) + F.lane;
#pragma unroll
        for (int j = 0; j < 4; ++j) { const int col = 4 * F.lane + 256 * j;
            const f32x4 g = *(const f32x4*)(ng + col), sh = *(const f32x4*)(mr + col), sc = *(const f32x4*)(mr + 1024 + col);
            const f32x4 y = (v[j] * rstd * g) * (sc + 1.0f) + sh;
            v2u w; w.x = pk2(y.x, y.y); w.y = pk2(y.z, y.w); o8[64 * j] = w; }
    }
}
__device__ __forceinline__ void final_norm_phase(const Frame& F) {
    const int gw = F.vcu * NWAVES + F.wave, NGW = F.G * NWAVES;
    for (int row = gw; row < MT; row += NGW) {
        GAS f32x4* xp = (GAS f32x4*)(F.out + (size_t)row * D) + F.lane;
        f32x4 v[4]; float ss = 0.f;
#pragma unroll
        for (int j = 0; j < 4; ++j) { v[j] = xp[64 * j]; ss += (v[j].x * v[j].x + v[j].y * v[j].y) + (v[j].z * v[j].z + v[j].w * v[j].w); }
        const float rstd = 1.0f / sqrtf(wave_sum(ss) * (1.0f / D) + EPS);
#pragma unroll
        for (int j = 0; j < 4; ++j) { const f32x4 g = *(const f32x4*)(F.final_g + 4 * F.lane + 256 * j); xp[64 * j] = v[j] * rstd * g; }
    }
}

constexpr int PB_OFF = 0, DM_OFF = 73728, DM_PITCH = 528, VN_PITCH = 272;
#define SCHED_FENCE() __builtin_amdgcn_sched_barrier(0)
__device__ __forceinline__ float sum16(float v) {
#pragma unroll
    for (int o = 1; o < 16; o <<= 1) v += __shfl_xor(v, o);
    return v;
}
__device__ __forceinline__ void mixer_tile(const Frame& F, int l, int ti) {
    int tid = F.tid; asm volatile("" : "+v"(tid));
    const int lane = tid & 63;
    const bool samp = ti >= 512;
    const int b = samp ? ti - 512 : ti >> 5, c = samp ? 0 : ti & 31;
    const int nTok = samp ? 16 : 128;
    const size_t row0 = samp ? (size_t)MP + b * 16 : (size_t)b * SEQ + c * 128;
    const int pos0 = samp ? 1024 : c * 128;
    const bf16* Zt = F.Z + row0 * NPAD;
    bf16* Yt = F.YC + row0 * D;
    LAS bf16* pbuf = (LAS bf16*)(F.lds + PB_OFF);
    LAS unsigned char* dmat = F.lds + DM_OFF;
    const int fr = lane & 15, fq = lane >> 4;
    const bool zhist = !samp && c > 0;
    {
        v4u val[8];
#pragma unroll
        for (int i = 0; i < 8; ++i) { const int idx = tid + 512 * i; val[i] = (v4u){0u, 0u, 0u, 0u};
            if (idx < nTok * 32) val[i] = *(const GAS v4u*)(Zt + (size_t)(idx >> 5) * NPAD + ZC_P + (idx & 31) * 8); }
        v4u hv = (v4u){0u, 0u, 0u, 0u};
        if (tid < 480) { const int r = tid >> 5, ch8 = (tid & 31) * 8;
            if (zhist) hv = *(const GAS v4u*)(Zt + (ptrdiff_t)(r - 15) * NPAD + ZC_P + ch8);
            else if (samp) { const float* sp = F.state_pool + ((size_t)(l * 16 + b) * 15 + r) * 256 + ch8; const f32x4 a = *(const f32x4*)sp, bb = *(const f32x4*)(sp + 4);
                hv.x = pk2(a.x, a.y); hv.y = pk2(a.z, a.w); hv.z = pk2(bb.x, bb.y); hv.w = pk2(bb.z, bb.w); } }
        SCHED_FENCE();
#pragma unroll
        for (int i = 0; i < 8; ++i) { const int idx = tid + 512 * i; if (idx < nTok * 32) *(LAS v4u*)(pbuf + 15 * 256 + idx * 8) = val[i]; }
        if (tid < 480) *(LAS v4u*)(pbuf + tid * 8) = hv;
    }
    __syncthreads();
    {
        const int ch = tid & 255, seg = tid >> 8, g = ch >> 6, w = 2 << g;
        const int t0 = seg * 64, len = samp ? (seg == 0 ? 16 : 0) : 64;
        if (len > 0) {
            float S = 0.f;
            for (int i = 1; i < w; ++i) S += bf2f(pbuf[(15 + t0 - i) * 256 + ch]);
#pragma unroll 8
            for (int t = t0; t < t0 + len; ++t) {
                const float pv = bf2f(pbuf[(15 + t) * 256 + ch]);
                S += pv;
                const int pc = pos0 + t + 1; const float cnt = (float)(pc < w ? pc : w);
                const float dv = S / cnt - pv;
                *(LAS bf16*)(dmat + t * DM_PITCH + ch * 2) = (bf16)f2bf(dv);
                S -= bf2f(pbuf[(15 + t - w + 1) * 256 + ch]);
            }
        }
    }
    __syncthreads();
    if (F.wave * 16 < nTok) {
        const int t = F.wave * 16 + fr;
        const bf16* zr = Zt + (size_t)t * NPAD; bf16* yr = Yt + (size_t)t * D;
        const bf16* WpT = F.WPT + l * 16384; const float* ps = F.pool_scale + l * 256;
        v4u zp[4][2];
#pragma unroll
        for (int g = 0; g < 4; ++g)
#pragma unroll
            for (int hh = 0; hh < 2; ++hh) zp[g][hh] = *(const GAS v4u*)(zr + ZC_ZP + g * 64 + 32 * hh + 8 * fq);
        SCHED_FENCE();
#pragma unroll
        for (int g = 0; g < 4; ++g) {
            bf16x8 bfr[2], afr[4][2]; f32x4 sc[2][2];
#pragma unroll
            for (int et = 0; et < 4; ++et) { const int e = 32 * (et >> 1) + 8 * (fr >> 2) + 4 * (et & 1) + (fr & 3);
#pragma unroll
                for (int kk = 0; kk < 2; ++kk) afr[et][kk] = *(const GAS bf16x8*)(WpT + (g * 64 + e) * 64 + 32 * kk + 8 * fq); }
#pragma unroll
            for (int hh = 0; hh < 2; ++hh) { sc[hh][0] = *(const f32x4*)(ps + g * 64 + 32 * hh + 8 * fq); sc[hh][1] = *(const f32x4*)(ps + g * 64 + 32 * hh + 8 * fq + 4); }
#pragma unroll
            for (int kk = 0; kk < 2; ++kk) bfr[kk] = *(const LAS bf16x8*)(dmat + t * DM_PITCH + (g * 64 + 32 * kk + 8 * fq) * 2);
            SCHED_FENCE();
            f32x4 acc[4];
#pragma unroll
            for (int et = 0; et < 4; ++et) { acc[et] = (f32x4){0.f, 0.f, 0.f, 0.f};
#pragma unroll
                for (int kk = 0; kk < 2; ++kk) acc[et] = __builtin_amdgcn_mfma_f32_16x16x32_bf16(afr[et][kk], bfr[kk], acc[et], 0, 0, 0); }
#pragma unroll
            for (int hh = 0; hh < 2; ++hh) { const int ch = g * 64 + 32 * hh + 8 * fq;
                float zv[8], o[8]; unpack8(zp[g][hh], zv);
#pragma unroll
                for (int i = 0; i < 4; ++i) { o[i] = acc[2 * hh][i] * sc[hh][0][i] * silu_f(zv[i]); o[4 + i] = acc[2 * hh + 1][i] * sc[hh][1][i] * silu_f(zv[4 + i]); }
                *(GAS v4u*)(yr + ch) = pack8(o); }
            SCHED_FENCE();
        }
    }
    if (samp || c == 31) {
        float* dst = F.out + (samp ? OFF_POOL_S : OFF_POOL_P) + (size_t)(l * 16 + b) * 15 * 256;
        const int rbase = samp ? 16 : 128;
        for (int idx = tid; idx < 15 * 256; idx += 512) dst[idx] = bf2f(pbuf[rbase * 256 + idx]);
    }
    __syncthreads();
    LAS unsigned char* vnT = F.lds;
    if (samp) for (int idx = tid; idx < 768; idx += 512) *(LAS v4u*)(vnT + (idx >> 1) * VN_PITCH + 32 + (idx & 1) * 16) = (v4u){0u, 0u, 0u, 0u};
    if (F.wave * 16 < nTok) {
        const int tb = F.wave * 16 + 4 * fq;
        v4u raw[4][3];
#pragma unroll
        for (int it = 0; it < 4; ++it)
#pragma unroll
            for (int j = 0; j < 3; ++j) raw[it][j] = *(const GAS v4u*)(Zt + (size_t)(tb + it) * NPAD + ZC_V + (fr + 16 * j) * 8);
        SCHED_FENCE();
#pragma unroll
        for (int pp = 0; pp < 2; ++pp) {
            float x[2][24]; float s1[2], s2[2];
#pragma unroll
            for (int e2 = 0; e2 < 2; ++e2) { s1[e2] = 0.f; s2[e2] = 0.f;
#pragma unroll
                for (int j = 0; j < 3; ++j) { float f[8]; unpack8(raw[2 * pp + e2][j], f);
#pragma unroll
                    for (int e = 0; e < 8; ++e) { x[e2][8 * j + e] = f[e]; s1[e2] += f[e]; s2[e2] += f[e] * f[e]; } } }
#pragma unroll
            for (int e2 = 0; e2 < 2; ++e2) { s1[e2] = sum16(s1[e2]); s2[e2] = sum16(s2[e2]); }
            float mu[2], rs[2];
#pragma unroll
            for (int e2 = 0; e2 < 2; ++e2) { mu[e2] = s1[e2] * (1.0f / 384.0f); const float var = fmaxf(s2[e2] * (1.0f / 384.0f) - mu[e2] * mu[e2], 0.f); rs[e2] = 1.0f / sqrtf(var + EPS); }
#pragma unroll
            for (int j = 0; j < 3; ++j) {
                const float* gp = F.v_norm_g + l * 384 + (fr + 16 * j) * 8; const float* bp = F.v_norm_b + l * 384 + (fr + 16 * j) * 8;
                const f32x4 g0 = *(const f32x4*)gp, g1 = *(const f32x4*)(gp + 4), b0 = *(const f32x4*)bp, b1 = *(const f32x4*)(bp + 4);
#pragma unroll
                for (int e = 0; e < 8; ++e) { const int k = 8 * j + e, cc = (fr + 16 * j) * 8 + e;
                    const float gmk = e < 4 ? g0[e & 3] : g1[e & 3], bek = e < 4 ? b0[e & 3] : b1[e & 3];
                    const float y0 = (x[0][k] - mu[0]) * rs[0] * gmk + bek, y1 = (x[1][k] - mu[1]) * rs[1] * gmk + bek;
                    x[0][k] = y0; x[1][k] = y1;
                    *(LAS unsigned*)(vnT + cc * VN_PITCH + (tb + 2 * pp) * 2) = pk2(y0, y1); } }
            SCHED_FENCE();
            if (samp) {
#pragma unroll
                for (int e2 = 0; e2 < 2; ++e2) { float* vo = F.out + OFF_V_S + ((size_t)(l * 16 + b) * 16 + tb + 2 * pp + e2) * 384;
#pragma unroll
                    for (int j = 0; j < 3; ++j) { float* vp = vo + (fr + 16 * j) * 8;
                        *(f32x4*)vp = (f32x4){x[e2][8 * j], x[e2][8 * j + 1], x[e2][8 * j + 2], x[e2][8 * j + 3]};
                        *(f32x4*)(vp + 4) = (f32x4){x[e2][8 * j + 4], x[e2][8 * j + 5], x[e2][8 * j + 6], x[e2][8 * j + 7]}; } }
            }
        }
    }
    __syncthreads();
    if (F.wave * 16 < nTok) {
        const int t = F.wave * 16 + fr; const int nk = samp ? 1 : 4;
        const bf16* zr = Zt + (size_t)t * NPAD; bf16* yr = Yt + (size_t)t * D;
        const bf16* Wl = F.WST + (size_t)l * 6 * 16384;
        bf16x8 wfr[2][4]; v4u up[2][2], zg[2][2]; float bsv[2];
#define GM_LOAD(h, s) do { _Pragma("unroll") for (int kk = 0; kk < 4; ++kk) wfr[s][kk] = (kk < nk) ? *(const GAS bf16x8*)(Wl + (size_t)((h) * 128 + t) * 128 + 32 * kk + 8 * fq) : (bf16x8){0, 0, 0, 0, 0, 0, 0, 0}; \
        _Pragma("unroll") for (int hh = 0; hh < 2; ++hh) { up[s][hh] = *(const GAS v4u*)(zr + ZC_U + (h) * 64 + 32 * hh + 8 * fq); zg[s][hh] = *(const GAS v4u*)(zr + ZC_ZG + (h) * 64 + 32 * hh + 8 * fq); } \
        bsv[s] = F.b_s[(l * 6 + (h)) * 128 + t]; } while (0)
        GM_LOAD(0, 0);
#pragma unroll
        for (int h = 0; h < 6; ++h) {
            const int s = h & 1;
            if (h + 1 < 6) GM_LOAD(h + 1, s ^ 1);
            SCHED_FENCE();
            f32x4 acc[4];
#pragma unroll
            for (int ct = 0; ct < 4; ++ct) { const int chrow = h * 64 + 32 * (ct >> 1) + 8 * (fr >> 2) + 4 * (ct & 1) + (fr & 3);
                acc[ct] = (f32x4){0.f, 0.f, 0.f, 0.f};
#pragma unroll
                for (int kk = 0; kk < 4; ++kk) if (kk < nk) { const bf16x8 a = *(const LAS bf16x8*)(vnT + chrow * VN_PITCH + (32 * kk + 8 * fq) * 2);
                    acc[ct] = __builtin_amdgcn_mfma_f32_16x16x32_bf16(a, wfr[s][kk], acc[ct], 0, 0, 0); } }
#pragma unroll
            for (int hh = 0; hh < 2; ++hh) { const int ch = h * 64 + 32 * hh + 8 * fq;
                float uv[8], zv[8], o[8]; unpack8(up[s][hh], uv); unpack8(zg[s][hh], zv);
#pragma unroll
                for (int i = 0; i < 4; ++i) { o[i] = uv[i] * (acc[2 * hh][i] + bsv[s]) * silu_f(zv[i]); o[4 + i] = uv[4 + i] * (acc[2 * hh + 1][i] + bsv[s]) * silu_f(zv[4 + i]); }
                *(GAS v4u*)(yr + 640 + ch) = pack8(o); }
            SCHED_FENCE();
        }
#undef GM_LOAD
    }
    {
        const int nItems = 48 * (nTok >> 2);
        float* cdst = F.out + (samp ? OFF_CONV_S : OFF_CONV_P) + (size_t)(l * 16 + b) * 2 * 384;
#pragma unroll 1
        for (int it = tid; it < nItems; it += 512) {
            const int chunk = it % 48, tg = it / 48, ch = chunk * 8, t0 = tg * 4;
            const bool hz = tg > 0 || zhist;
            v4u gcr[6], hxr[6], gbr[4], zcr[4];
#pragma unroll
            for (int r = 0; r < 6; ++r) { gcr[r] = (v4u){0u, 0u, 0u, 0u}; hxr[r] = (v4u){0u, 0u, 0u, 0u};
                if (r >= 2 || hz) { const bf16* zr = Zt + (ptrdiff_t)(t0 - 2 + r) * NPAD; gcr[r] = *(const GAS v4u*)(zr + ZC_GC + ch); hxr[r] = *(const GAS v4u*)(zr + ZC_HX + ch); } }
#pragma unroll
            for (int r = 0; r < 4; ++r) { const bf16* zr = Zt + (size_t)(t0 + r) * NPAD; gbr[r] = *(const GAS v4u*)(zr + ZC_GB + ch); zcr[r] = *(const GAS v4u*)(zr + ZC_ZC + ch); }
            float w0[8], w1[8], w2[8];
            { const float* wc = F.w_conv + l * 3 * 384 + ch;
#pragma unroll
              for (int k = 0; k < 2; ++k) { const f32x4 a = *(const f32x4*)(wc + 4 * k), bq = *(const f32x4*)(wc + 384 + 4 * k), cq = *(const f32x4*)(wc + 768 + 4 * k);
#pragma unroll
                  for (int e = 0; e < 4; ++e) { w0[4 * k + e] = a[e]; w1[4 * k + e] = bq[e]; w2[4 * k + e] = cq[e]; } } }
            float q[6][8];
            if (!hz && samp) { const float* sp = F.state_conv + (size_t)(l * 16 + b) * 2 * 384 + ch;
#pragma unroll
                for (int k = 0; k < 2; ++k) { const f32x4 a = *(const f32x4*)(sp + 4 * k), bq = *(const f32x4*)(sp + 384 + 4 * k);
#pragma unroll
                    for (int e = 0; e < 4; ++e) { q[0][4 * k + e] = a[e]; q[1][4 * k + e] = bq[e]; } } }
            SCHED_FENCE();
#pragma unroll
            for (int r = 0; r < 6; ++r) { if (r >= 2 || hz || !samp) { float a[8], bq[8]; unpack8(gcr[r], a); unpack8(hxr[r], bq);
#pragma unroll
                for (int e = 0; e < 8; ++e) q[r][e] = a[e] * bq[e]; } }
#pragma unroll
            for (int r = 0; r < 4; ++r) { float gb[8], zc[8], o[8]; unpack8(gbr[r], gb); unpack8(zcr[r], zc);
#pragma unroll
                for (int e = 0; e < 8; ++e) o[e] = gb[e] * (w0[e] * q[r][e] + w1[e] * q[r + 1][e] + w2[e] * q[r + 2][e]) * silu_f(zc[e]);
                *(GAS v4u*)(Yt + (size_t)(t0 + r) * D + 256 + ch) = pack8(o); }
            if (t0 + 4 == nTok && (samp || c == 31)) {
#pragma unroll
                for (int r = 0; r < 2; ++r) { float* dp = cdst + r * 384 + ch;
                    *(f32x4*)dp = (f32x4){q[4 + r][0], q[4 + r][1], q[4 + r][2], q[4 + r][3]}; *(f32x4*)(dp + 4) = (f32x4){q[4 + r][4], q[4 + r][5], q[4 + r][6], q[4 + r][7]}; } }
        }
    }
    __syncthreads();
}
__device__ __forceinline__ void mixer_phase(const Frame& F, int l) {
    for (int ti = F.vcu; ti < 512 + 16; ti += F.G) mixer_tile(F, l, ti);
}

template <int MODE>
__device__ __forceinline__ void skinny_item(const Frame& F, int l, int item) {
    const int fr = F.lane & 15, fq = F.lane >> 4, n0 = item * 16;
    const bf16* A = (MODE == 0 ? F.H : F.YC) + (size_t)MP * D;
    const bf16* Bt = MODE == 0 ? F.WIN + (size_t)l * NPAD * D : F.WOUT + (size_t)l * D * D;
    const bf16* brow = Bt + (size_t)(n0 + fr) * D + 8 * fq;
    const bf16* arow = A + (size_t)(32 * F.wave + fr) * D + 8 * fq;
    f32x4 acc0 = (f32x4){0.f, 0.f, 0.f, 0.f}, acc1 = acc0;
#pragma unroll 1
    for (int kc = 0; kc < 4; ++kc) {
        bf16x8 wv[8], a0[8], a1[8];
#pragma unroll
        for (int j = 0; j < 8; ++j) { const int ko = (kc * 8 + j) * 32; wv[j] = *(const GAS bf16x8*)(brow + ko); a0[j] = *(const GAS bf16x8*)(arow + ko); a1[j] = *(const GAS bf16x8*)(arow + 16 * D + ko); }
        __builtin_amdgcn_sched_barrier(0);
#pragma unroll
        for (int j = 0; j < 8; ++j) { acc0 = __builtin_amdgcn_mfma_f32_16x16x32_bf16(wv[j], a0[j], acc0, 0, 0, 0); acc1 = __builtin_amdgcn_mfma_f32_16x16x32_bf16(wv[j], a1[j], acc1, 0, 0, 0); }
        __builtin_amdgcn_sched_barrier(0);
    }
#pragma unroll
    for (int tt = 0; tt < 2; ++tt) {
        const f32x4 a = tt == 0 ? acc0 : acc1; const int t = 32 * F.wave + 16 * tt + fr, nn = n0 + 4 * fq;
        if (MODE == 0) { v2u w; w.x = pk2(a.x, a.y); w.y = pk2(a.z, a.w); *(GAS v2u*)(F.Z + (size_t)(MP + t) * NPAD + nn) = w; }
        else { const float* bp = (l == 0 ? F.x_sample : F.out + (size_t)MP * D) + (size_t)t * D + nn;
            const f32x4 g = *(const f32x4*)(F.mod + ((size_t)l * 32 + 16 + (t >> 4)) * 3072 + 2048 + nn), b = *(const f32x4*)bp;
            *(f32x4*)(F.out + (size_t)(MP + t) * D + nn) = b + g * a; }
    }
}
template <int MODE>
__device__ __forceinline__ void skinny_phase(const Frame& F, int l) {
    const int nitems = MODE == 0 ? NPROJ / 16 : D / 16;
    for (int it = F.vcu; it < nitems; it += F.G) skinny_item<MODE>(F, l, it);
}

struct Args { const float* in[19]; float* out; unsigned char* ws; int ph_lo, ph_hi; };
__global__ void __launch_bounds__(NWAVES * 64, 2) fwd(Args args) {
    extern __shared__ __attribute__((aligned(16))) unsigned char lds_raw[];
    const int lo = args.ph_lo, hi = args.ph_hi;
#define MAKE_FRAME() Frame F; { int tid_ = threadIdx.x; asm volatile("" : "+v"(tid_)); const CAS Args* ap = (const CAS Args*)__builtin_amdgcn_kernarg_segment_ptr(); asm volatile("" : "+s"(ap)); \
    F.lds = (LAS unsigned char*)lds_raw; F.tid = tid_; F.lane = F.tid & 63; F.wave = __builtin_amdgcn_readfirstlane(F.tid >> 6); \
    F.G = gridDim.x; { const int bx = blockIdx.x; F.vcu = (F.G % 8 == 0) ? (bx % 8) * (F.G / 8) + bx / 8 : bx; } \
    F.x_prompt = ap->in[0]; F.x_sample = ap->in[1]; F.state_pool = ap->in[2]; F.state_conv = ap->in[3]; F.c_prompt = ap->in[4]; F.c_sample = ap->in[5]; \
    F.norm_g = ap->in[6]; F.w_ada = ap->in[7]; F.b_ada = ap->in[8]; F.w_in = ap->in[9]; F.w_pool = ap->in[10]; F.pool_scale = ap->in[11]; F.w_conv = ap->in[12]; \
    F.v_norm_g = ap->in[13]; F.v_norm_b = ap->in[14]; F.w_s = ap->in[15]; F.b_s = ap->in[16]; F.w_out = ap->in[17]; F.final_g = ap->in[18]; \
    F.out = ap->out; unsigned char* ws = ap->ws; \
    F.mod = (float*)(ws + WS_MOD); F.WST = (bf16*)(ws + WS_WST); F.WPT = (bf16*)(ws + WS_WPT); F.WOUT = (bf16*)(ws + WS_WOUT); F.WIN = (bf16*)(ws + WS_WIN); \
    F.H = (bf16*)(ws + WS_H); F.YC = (bf16*)(ws + WS_YC); F.Z = (bf16*)(ws + WS_Z); }
#if MK_MODE == 1
    cg::grid_group grid = cg::this_grid();
#define GRID_BAR() grid.sync()
#elif MK_MODE == 2
    if (threadIdx.x < 2) ((LAS unsigned*)(lds_raw + MISC_OFF))[threadIdx.x] = 0u;
    __syncthreads();
    if (hi - lo > 1) { const CAS Args* ap0 = (const CAS Args*)__builtin_amdgcn_kernarg_segment_ptr(); (void)xcd_barrier_post((unsigned*)(ap0->ws + WS_CTL) + CW_BAR, (volatile LAS unsigned*)(lds_raw + MISC_OFF)); }
#define GRID_BAR() do { const CAS Args* apb = (const CAS Args*)__builtin_amdgcn_kernarg_segment_ptr(); asm volatile("" : "+s"(apb)); XcdBarrier xb_; xb_.bar = (unsigned*)(apb->ws + WS_CTL) + CW_BAR; xb_.x = xb_xcc_id(); \
    xb_.st = (volatile LAS unsigned*)(lds_raw + MISC_OFF); xcd_barrier(xb_); } while (0)
#else
#define GRID_BAR() do {} while (0)
#endif
#define IN(k) (lo <= (k) && (k) < hi)
#define SEAM(k) do { if (IN(k) && IN((k) + 1)) GRID_BAR(); } while (0)

#define REPS(k) (1 + ((REP_MASK >> (k)) & 1))
    if (IN(0)) {
#pragma unroll 1
        for (int rp = 0; rp < REPS(0); ++rp) { MAKE_FRAME(); p0_prologue(F); if (rp + 1 < REPS(0)) GRID_BAR(); }
        SEAM(0); }
#pragma unroll 1
    for (int l = 0; l < 2; ++l) {
        const int pb = 1 + 4 * l;
        if (IN(pb)) {
#pragma unroll 1
            for (int rp = 0; rp < REPS(pb); ++rp) { MAKE_FRAME(); norm_phase(F, l); if (rp + 1 < REPS(pb)) GRID_BAR(); }
            SEAM(pb); }
        if (IN(pb + 1)) {
#pragma unroll 1
            for (int rp = 0; rp < REPS(pb + 1); ++rp) {
            MAKE_FRAME(); skinny_phase<0>(F, l);
            pg8::Gemm g{F.H, F.WIN + (size_t)l * NPAD * D, MP, NPAD, D}; pg8::StaticOrder S; S.init(MP, NPAD, F.G, (int)blockIdx.x);
            pg8::EpiZ E{F.Z, NPAD};
            TEL_DECL; TEL_START(5, threadIdx.x == 0);
            pg8::gemm_phase<pg8::EpiZ, pg8::StaticOrder, PG8_ALIGN, PG8_SP2>(F.lds, g, S, E, (unsigned char*)F.mod - WS_MOD + TEL_WORD_OFF);
            TEL_STOP(5, threadIdx.x == 0, (unsigned char*)F.mod - WS_MOD + TEL_WORD_OFF);
            if (rp + 1 < REPS(pb + 1)) GRID_BAR(); }
            { TEL_DECL; TEL_START(7, threadIdx.x == 0); SEAM(pb + 1); const CAS Args* apq = (const CAS Args*)__builtin_amdgcn_kernarg_segment_ptr(); TEL_STOP(7, threadIdx.x == 0, apq->ws + TEL_WORD_OFF); }
        }
        if (IN(pb + 2)) {
#pragma unroll 1
            for (int rp = 0; rp < REPS(pb + 2); ++rp) { MAKE_FRAME(); mixer_phase(F, l); if (rp + 1 < REPS(pb + 2)) GRID_BAR(); }
            SEAM(pb + 2); }
        if (IN(pb + 3)) {
#pragma unroll 1
            for (int rp = 0; rp < REPS(pb + 3); ++rp) {
            MAKE_FRAME(); skinny_phase<1>(F, l);
            pg8::Gemm g{F.YC, F.WOUT + (size_t)l * D * D, MP, D, D}; pg8::StaticOrder S; S.init(MP, D, F.G, (int)blockIdx.x);
            pg8::EpiRes E{l == 0 ? F.x_prompt : F.out, F.out, F.mod + (size_t)l * 32 * 3072 + 2048};
            pg8::gemm_phase<pg8::EpiRes, pg8::StaticOrder, PG8_ALIGN, PG8_SP2>(F.lds, g, S, E, (unsigned char*)F.mod - WS_MOD + TEL_WORD_OFF);
            if (rp + 1 < REPS(pb + 3)) GRID_BAR(); }
            SEAM(pb + 3);
        }
    }
    if (IN(9)) { MAKE_FRAME(); final_norm_phase(F); }
#if TELEM
    if (blockIdx.x == TEL_WG && threadIdx.x == 0 && hi == NPHASE) {
        const CAS Args* apt = (const CAS Args*)__builtin_amdgcn_kernarg_segment_ptr();
        const unsigned long long v = __hip_atomic_load((unsigned long long*)(apt->ws + TEL_WORD_OFF), __ATOMIC_RELAXED, __HIP_MEMORY_SCOPE_AGENT);
        const unsigned long long want = (TELEM & 1) ? v * 4ull : v / 50ull;
        const unsigned long long t0 = __builtin_amdgcn_s_memrealtime();
        while ((unsigned long long)__builtin_amdgcn_s_memrealtime() - t0 < want) __builtin_amdgcn_s_sleep(8);
    }
#endif
#undef IN
#undef SEAM
}

extern "C" void kernel_launch(void* const* d_in, const int* in_sizes, int n_in, void* d_out, int out_size, void* d_ws, size_t ws_size, hipStream_t stream) {
    static int grid = 0;
    if (grid == 0) {
        if (n_in != 19 || ws_size < WS_END) { fprintf(stderr, "kernel_launch: expected 19 inputs and >= %zu bytes of workspace; got n_in %d, ws %zu\n", (size_t)WS_END, n_in, ws_size); grid = -1; return; }
        int dev = 0, cus = 0, per_cu = 0;
        if (hipGetDevice(&dev) != hipSuccess || hipDeviceGetAttribute(&cus, hipDeviceAttributeMultiprocessorCount, dev) != hipSuccess) { grid = -1; return; }
        if (hipFuncSetAttribute((const void*)fwd, hipFuncAttributeMaxDynamicSharedMemorySize, LDS_BYTES) != hipSuccess) { fprintf(stderr, "kernel_launch: hipFuncSetAttribute failed\n"); grid = -1; return; }
        if (hipOccupancyMaxActiveBlocksPerMultiprocessor(&per_cu, (const void*)fwd, NWAVES * 64, LDS_BYTES) != hipSuccess || per_cu < 1) { fprintf(stderr, "kernel_launch: occupancy query says %d blocks per CU\n", per_cu); (void)hipGetLastError(); per_cu = 1; }
        grid = cus;
    }
    if (grid < 0) return;
    (void)hipMemsetAsync((char*)d_ws + WS_CTL, 0, CTL_ZERO_BYTES, stream);
    Args a{};
    for (int i = 0; i < 19; ++i) a.in[i] = (const float*)d_in[i];
    a.out = (float*)d_out; a.ws = (unsigned char*)d_ws;
#if MK_MODE == 2
    a.ph_lo = 0; a.ph_hi = NPHASE;
    hipLaunchKernelGGL(fwd, dim3(grid), dim3(NWAVES * 64), LDS_BYTES, stream, a);
    { const hipError_t le = hipPeekAtLastError(); if (le != hipSuccess) fprintf(stderr, "kernel_launch: launch failed: %s\n", hipGetErrorName(le)); }
#elif MK_MODE == 0
    for (int ph = 0; ph < NPHASE; ++ph) { a.ph_lo = ph; a.ph_hi = ph + 1; hipLaunchKernelGGL(fwd, dim3(grid), dim3(NWAVES * 64), LDS_BYTES, stream, a);
        const hipError_t le = hipPeekAtLastError(); if (le != hipSuccess) { fprintf(stderr, "kernel_launch: launch %d failed: %s\n", ph, hipGetErrorName(le)); break; } }
#else
    a.ph_lo = 0; a.ph_hi = NPHASE;
    void* kargs[] = {&a};
    const hipError_t le = hipLaunchCooperativeKernel((const void*)fwd, dim3(grid), dim3(NWAVES * 64), kargs, LDS_BYTES, stream);
    if (le != hipSuccess) fprintf(stderr, "kernel_launch: cooperative launch failed: %s (grid %d)\n", hipGetErrorName(le), grid);
#endif
}
```

```cpp
#include <hip/hip_runtime.h>
#include <hip/hip_cooperative_groups.h>
#include <cstdio>
#include <cstdint>
#include <cstddef>
namespace cg = cooperative_groups;
#ifndef TELEM
#define TELEM 0
#endif
#define TEL_WORD_OFF 16384
#if TELEM
#define TEL_DECL unsigned long long tel_t0_ = 0ull
#ifndef TEL_WG
#define TEL_WG 0
#endif
#define TEL_ON(id, leader) ((TELEM) == (id) && blockIdx.x == TEL_WG && (leader))
#define TEL_START(id, leader) do { if (TEL_ON(id, leader)) tel_t0_ = ((id) & 1) ? (unsigned long long)__builtin_amdgcn_s_memrealtime() : (unsigned long long)__builtin_readcyclecounter(); } while (0)
#define TEL_STOP(id, leader, telp) do { if (TEL_ON(id, leader)) { const unsigned long long t1_ = ((id) & 1) ? (unsigned long long)__builtin_amdgcn_s_memrealtime() : (unsigned long long)__builtin_readcyclecounter(); \
    __hip_atomic_fetch_add((unsigned long long*)(telp), t1_ - tel_t0_, __ATOMIC_RELAXED, __HIP_MEMORY_SCOPE_AGENT); } } while (0)
#else
#define TEL_DECL
#define TEL_START(id, leader) do {} while (0)
#define TEL_STOP(id, leader, telp) do {} while (0)
#endif
#ifndef PROBE_EPI2
#define PROBE_EPI2 0
#endif
namespace pg8 {
#define PG8_LAS __attribute__((address_space(3)))
typedef unsigned short bf16_t;
typedef short bf16x8 __attribute__((ext_vector_type(8)));
typedef float f32x4 __attribute__((ext_vector_type(4)));
typedef unsigned u32x4 __attribute__((ext_vector_type(4)));
constexpr int BM = 256, BK = 64, HALF = 128, HTB = HALF * BK * 2  , STAGE_BYTES = 8 * HTB, NXCD = 8, WGM = 8;

__host__ __device__ __forceinline__ int lds_byte(int r, int c) { const int st = (r >> 4) * 2 + (c >> 5), rr = r & 15, cc = c & 31, ob = rr * 64 + cc * 2; return st * 1024 + (ob ^ (((ob >> 9) & 1) << 5)); }
__host__ __device__ __forceinline__ void stage_rc(int b, int& R, int& C) { const int st = b / 1024, sb = b % 1024, swz = sb ^ (((sb >> 9) & 1) << 5); R = (st >> 1) * 16 + swz / 64; C = (st & 1) * 32 + (swz % 64) / 2; }
__host__ __device__ __forceinline__ int perm32(int rho) { const int n = rho >> 4, i = rho & 15; return 8 * (i >> 2) + 4 * n + (i & 3); }

struct Unit { int pm, pn; };
struct Gemm { const bf16_t* A; const bf16_t* Bt; int M, N, K; };

struct StaticOrder {
    int nM, nN, nwg, G, c;
    __host__ __device__ void init(int M, int N, int G_, int c_) { nM = M / BM; nN = N / BM; nwg = nM * nN; G = G_; c = c_; }
    __host__ __device__ bool next(int i, Unit& u) const {
        const long L = (long)i * G + c; if (L >= nwg) return false;
        int wgid = (int)L; { const int q = nwg / NXCD, r = nwg % NXCD, xcd = wgid % NXCD, off = wgid / NXCD; wgid = (xcd < r ? xcd * (q + 1) : r * (q + 1) + (xcd - r) * q) + off; }
        const int nig = WGM * nN, gid = wgid / nig, fm = gid * WGM, gsz = (nM - fm) < WGM ? (nM - fm) : WGM;
        u.pm = fm + ((wgid % nig) % gsz); u.pn = (wgid % nig) / gsz; return true;
    }
    __device__ __forceinline__ void a_ready(const Unit&) const {}
    __device__ __forceinline__ void done(const Unit&) const {}
};


__device__ __forceinline__ unsigned cvt_pk_bf16(float lo, float hi) { unsigned r; asm volatile("v_cvt_pk_bf16_f32 %0, %1, %2" : "=v"(r) : "v"(lo), "v"(hi)); return r; }

struct EpiZ {
    static constexpr bool PERM = true, AFTER_DRAIN = false; static constexpr int TEL_ID = 1;
    bf16_t* O; int ldc;
    __device__ __forceinline__ bool probe_twice() const { return PROBE_EPI2 == 1; }
    __device__ __forceinline__ void operator()(const f32x4 (&acc)[2][2][4][2], const Unit& u, int wr, int wc, int fr, int fq) const {
        const int row0 = u.pm * BM + wr * 64 + fr, col0 = u.pn * BM + wc * 32 + 8 * fq;
#pragma unroll
        for (int ai = 0; ai < 2; ++ai)
#pragma unroll
            for (int m = 0; m < 4; ++m) { bf16_t* rowp = O + (size_t)(row0 + ai * HALF + m * 16) * ldc + col0;
#pragma unroll
                for (int bj = 0; bj < 2; ++bj) { const f32x4 v0 = acc[ai][bj][m][0], v1 = acc[ai][bj][m][1];
                    u32x4 w; w.x = cvt_pk_bf16(v0[0], v0[1]); w.y = cvt_pk_bf16(v0[2], v0[3]); w.z = cvt_pk_bf16(v1[0], v1[1]); w.w = cvt_pk_bf16(v1[2], v1[3]);
                    *(u32x4*)(rowp + bj * HALF) = w; } }
    }
};
struct EpiRes {
    static constexpr bool PERM = false, AFTER_DRAIN = false; static constexpr int TEL_ID = 3;
    const float* base; float* out; const float* gate;
    __device__ __forceinline__ bool probe_twice() const { return PROBE_EPI2 == 2 && base != out; }
    __device__ __forceinline__ void operator()(const f32x4 (&acc)[2][2][4][2], const Unit& u, int wr, int wc, int fr, int fq) const {
        const int col0 = u.pn * BM + wc * 32 + 4 * fq;
        const float* gp = gate + (size_t)(u.pm >> 4) * 3072 + col0;
        f32x4 gv[2][2];
#pragma unroll
        for (int bj = 0; bj < 2; ++bj)
#pragma unroll
            for (int n = 0; n < 2; ++n) gv[bj][n] = *(const f32x4*)(gp + bj * HALF + n * 16);
#pragma unroll
        for (int ai = 0; ai < 2; ++ai) {
            const size_t off = (size_t)(u.pm * BM + ai * HALF + wr * 64 + fr) * 1024 + col0;
            f32x4 bv[4][2][2];
#pragma unroll
            for (int m = 0; m < 4; ++m)
#pragma unroll
                for (int bj = 0; bj < 2; ++bj)
#pragma unroll
                    for (int n = 0; n < 2; ++n) bv[m][bj][n] = *(const f32x4*)(base + off + (size_t)m * 16 * 1024 + bj * HALF + n * 16);
#pragma unroll
            for (int m = 0; m < 4; ++m)
#pragma unroll
                for (int bj = 0; bj < 2; ++bj)
#pragma unroll
                    for (int n = 0; n < 2; ++n) *(f32x4*)(out + off + (size_t)m * 16 * 1024 + bj * HALF + n * 16) = bv[m][bj][n] + gv[bj][n] * acc[ai][bj][m][n];
            asm volatile("" ::: "memory"); }
    }
};

template <class Epi, class Sched, bool ALIGN_EPI = false, bool SP2 = false>
__device__ __forceinline__ void gemm_phase(PG8_LAS unsigned char* lds, const Gemm g, const Sched& S, const Epi& E, unsigned char* telp = nullptr) {
    TEL_DECL;
    int tid_ = threadIdx.x; asm volatile("" : "+v"(tid_));
    const int tid = tid_, wid = __builtin_amdgcn_readfirstlane(tid >> 6), lane = tid & 63, wr = wid >> 2, wc = wid & 3, fr = lane & 15, fq = lane >> 4;
    const int K = g.K, nt = K / BK;
    unsigned voffA[2], voffB[2];
#pragma unroll
    for (int i = 0; i < 2; ++i) { int R, C; stage_rc(tid * 16 + i * 8192, R, C); const int Rb = Epi::PERM ? ((R & ~31) + perm32(R & 31)) : R;
        voffA[i] = (unsigned)(R * K + C) * 2u; voffB[i] = (unsigned)(Rb * K + C) * 2u; }
    const size_t kstep = (size_t)(BK * 2);
    const size_t hstep = (size_t)HALF * K * 2;
    const size_t tstep = 2 * hstep;
    const unsigned ldsw = (unsigned)wid * 1024u;
    const int aoff = lds_byte(wr * 64 + fr, fq * 8), boff = lds_byte(wc * 32 + fr, fq * 8);
#define PG8_SA(b, h) (((b) * 2 + (h)) * HTB)
#define PG8_SB(b, h) ((4 + (b) * 2 + (h)) * HTB)
#define PG8_STAGE(bufoff, gbase, voff) do { _Pragma("unroll") for (int _i = 0; _i < 2; ++_i) \
        __builtin_amdgcn_global_load_lds((const unsigned*)((const char*)(gbase) + (voff)[_i]), (PG8_LAS unsigned*)(lds + (bufoff) + ldsw + _i * 8192), 16, 0, 0); } while (0)
#define PG8_LDA(dst, b, h) do { _Pragma("unroll") for (int m = 0; m < 4; ++m) _Pragma("unroll") for (int k = 0; k < 2; ++k) dst[m][k] = *(const PG8_LAS bf16x8*)(lds + PG8_SA(b, h) + aoff + m * 2048 + k * 1024); } while (0)
#define PG8_LDB(dst, b, h) do { _Pragma("unroll") for (int n = 0; n < 2; ++n) _Pragma("unroll") for (int k = 0; k < 2; ++k) dst[n][k] = *(const PG8_LAS bf16x8*)(lds + PG8_SB(b, h) + boff + n * 2048 + k * 1024); } while (0)
#define PG8_MMA(ai, bj, At, Bt) do { __builtin_amdgcn_s_setprio(1); _Pragma("unroll") for (int m = 0; m < 4; ++m) _Pragma("unroll") for (int n = 0; n < 2; ++n) _Pragma("unroll") for (int k = 0; k < 2; ++k) \
        acc[ai][bj][m][n] = __builtin_amdgcn_mfma_f32_16x16x32_bf16(Bt[n][k], At[m][k], acc[ai][bj][m][n], 0, 0, 0); __builtin_amdgcn_s_setprio(0); } while (0)
#define PG8_WAIT_V(n) asm volatile("s_waitcnt vmcnt(" #n ")" ::: "memory")
#define PG8_WAIT_L(n) asm volatile("s_waitcnt lgkmcnt(" #n ")" ::: "memory")
#define PG8_BAR __builtin_amdgcn_s_barrier()
#define PG8_SCHED __builtin_amdgcn_sched_barrier(0)
    Unit cur, nxt; int ui = 0;
    if (!S.next(0, cur)) return;
    f32x4 acc[2][2][4][2];
#pragma unroll
    for (int a = 0; a < 2; ++a)
#pragma unroll
        for (int b = 0; b < 2; ++b)
#pragma unroll
            for (int m = 0; m < 4; ++m)
#pragma unroll
                for (int n = 0; n < 2; ++n) acc[a][b][m][n] = (f32x4){0.f, 0.f, 0.f, 0.f};
    bf16x8 At[4][2], B0[2][2], B1[2][2];
    const char* cA = (const char*)g.A + (size_t)cur.pm * tstep; const char* cB = (const char*)g.Bt + (size_t)cur.pn * tstep;
    S.a_ready(cur);
    if constexpr (SP2) {
        PG8_STAGE(PG8_SB(0, 0), cB, voffB); PG8_STAGE(PG8_SB(0, 1), cB + hstep, voffB); PG8_STAGE(PG8_SA(0, 0), cA, voffA); PG8_STAGE(PG8_SA(0, 1), cA + hstep, voffA);
        if (wr == 1) PG8_BAR;
        PG8_WAIT_V(2); PG8_BAR;
        PG8_STAGE(PG8_SB(1, 0), cB + kstep, voffB); PG8_STAGE(PG8_SA(1, 0), cA + kstep, voffA); PG8_STAGE(PG8_SB(1, 1), cB + hstep + kstep, voffB);
        PG8_WAIT_V(6); PG8_BAR;
    } else {
        PG8_STAGE(PG8_SB(0, 0), cB, voffB); PG8_STAGE(PG8_SA(0, 0), cA, voffA); PG8_STAGE(PG8_SB(0, 1), cB + hstep, voffB); PG8_STAGE(PG8_SA(0, 1), cA + hstep, voffA);
        if (wr == 1) PG8_BAR;
        PG8_WAIT_V(4); PG8_BAR;
        PG8_STAGE(PG8_SB(1, 0), cB + kstep, voffB); PG8_STAGE(PG8_SA(1, 0), cA + kstep, voffA); PG8_STAGE(PG8_SB(1, 1), cB + hstep + kstep, voffB);
        PG8_WAIT_V(6); PG8_BAR;
    }
    for (;;) {
        const bool has_next = S.next(ui + 1, nxt);
        const char* nA = has_next ? (const char*)g.A + (size_t)nxt.pm * tstep : cA; const char* nB = has_next ? (const char*)g.Bt + (size_t)nxt.pn * tstep : cB;
        TEL_START(Epi::TEL_ID, tid == 0); TEL_START(Epi::TEL_ID + 1, tid == 0);
        for (int t = 0; t < nt; t += 2) {
            const bool last = (t == nt - 2);
            const char* a1 = cA + (size_t)(t + 1) * kstep;
            const char* a2 = last ? nA : cA + (size_t)(t + 2) * kstep; const char* b2 = last ? nB : cB + (size_t)(t + 2) * kstep;
            const char* a3 = a2 + kstep; const char* b3 = b2 + kstep;
            if (last && has_next) S.a_ready(nxt);
            if constexpr (SP2) {
            PG8_LDB(B0, 0, 0); PG8_LDB(B1, 0, 1); PG8_SCHED; PG8_LDA(At, 0, 0); PG8_STAGE(PG8_SA(1, 1), a1 + hstep, voffA);
            PG8_WAIT_V(8); PG8_WAIT_L(0); PG8_BAR; PG8_MMA(0, 0, At, B0); PG8_MMA(0, 1, At, B1); PG8_BAR; PG8_SCHED;
            PG8_LDA(At, 0, 1); PG8_STAGE(PG8_SB(0, 0), b2, voffB); PG8_STAGE(PG8_SB(0, 1), b2 + hstep, voffB); PG8_STAGE(PG8_SA(0, 0), a2, voffA);
            PG8_WAIT_V(8); PG8_WAIT_L(0); PG8_BAR; PG8_MMA(1, 0, At, B0); PG8_MMA(1, 1, At, B1); PG8_BAR; PG8_SCHED;
            PG8_LDB(B0, 1, 0); PG8_LDB(B1, 1, 1); PG8_SCHED; PG8_LDA(At, 1, 0); PG8_STAGE(PG8_SA(0, 1), a2 + hstep, voffA);
            PG8_WAIT_V(8); PG8_WAIT_L(0); PG8_BAR; PG8_MMA(0, 0, At, B0); PG8_MMA(0, 1, At, B1); PG8_BAR; PG8_SCHED;
            PG8_LDA(At, 1, 1); PG8_STAGE(PG8_SB(1, 0), b3, voffB); PG8_STAGE(PG8_SB(1, 1), b3 + hstep, voffB); PG8_STAGE(PG8_SA(1, 0), a3, voffA);
            PG8_WAIT_V(8); PG8_WAIT_L(0); PG8_BAR; PG8_MMA(1, 0, At, B0); PG8_MMA(1, 1, At, B1); PG8_BAR; PG8_SCHED;
            } else {
            PG8_LDB(B0, 0, 0); PG8_SCHED; PG8_LDA(At, 0, 0); PG8_STAGE(PG8_SA(1, 1), a1 + hstep, voffA);
            PG8_WAIT_L(8); PG8_BAR; PG8_WAIT_L(0); PG8_MMA(0, 0, At, B0); PG8_BAR; PG8_SCHED;
            PG8_LDB(B1, 0, 1); PG8_STAGE(PG8_SB(0, 0), b2, voffB);
            PG8_BAR; PG8_WAIT_L(0); PG8_MMA(0, 1, At, B1); PG8_BAR;
            PG8_LDA(At, 0, 1); PG8_STAGE(PG8_SA(0, 0), a2, voffA);
            PG8_BAR; PG8_WAIT_L(0); PG8_MMA(1, 0, At, B0); PG8_BAR; PG8_SCHED;
            PG8_STAGE(PG8_SB(0, 1), b2 + hstep, voffB);
            PG8_WAIT_V(6); PG8_BAR; PG8_MMA(1, 1, At, B1); PG8_BAR;
            PG8_LDB(B0, 1, 0); PG8_SCHED; PG8_LDA(At, 1, 0); PG8_STAGE(PG8_SA(0, 1), a2 + hstep, voffA);
            PG8_WAIT_L(8); PG8_BAR; PG8_WAIT_L(0); PG8_MMA(0, 0, At, B0); PG8_BAR; PG8_SCHED;
            PG8_LDB(B1, 1, 1); PG8_STAGE(PG8_SB(1, 0), b3, voffB);
            PG8_BAR; PG8_WAIT_L(0); PG8_MMA(0, 1, At, B1); PG8_BAR;
            PG8_LDA(At, 1, 1); PG8_STAGE(PG8_SA(1, 0), a3, voffA);
            PG8_BAR; PG8_WAIT_L(0); PG8_MMA(1, 0, At, B0); PG8_BAR; PG8_SCHED;
            PG8_STAGE(PG8_SB(1, 1), b3 + hstep, voffB);
            PG8_WAIT_V(6); PG8_BAR; PG8_MMA(1, 1, At, B1); PG8_BAR;
            }
        }
        TEL_STOP(Epi::TEL_ID, tid == 0, telp); TEL_STOP(Epi::TEL_ID + 1, tid == 0, telp);
        if constexpr (ALIGN_EPI) { if (wr == 0) PG8_BAR; }
        if constexpr (!Epi::AFTER_DRAIN) { E(acc, cur, wr, wc, fr, fq);
#if defined(PROBE_EPI2)
            if (E.probe_twice()) { asm volatile("" ::: "memory"); E(acc, cur, wr, wc, fr, fq); }
#endif
            S.done(cur); }
        if (!has_next) break;
#pragma unroll
        for (int a = 0; a < 2; ++a)
#pragma unroll
            for (int b = 0; b < 2; ++b)
#pragma unroll
                for (int m = 0; m < 4; ++m)
#pragma unroll
                    for (int n = 0; n < 2; ++n) acc[a][b][m][n] = (f32x4){0.f, 0.f, 0.f, 0.f};
        cur = nxt; cA = nA; cB = nB; ++ui;
        if constexpr (ALIGN_EPI) { if (wr == 1) PG8_BAR; }
    }
    PG8_WAIT_V(0);
    if constexpr (!ALIGN_EPI) { if (wr == 0) PG8_BAR; }
    PG8_BAR;
    if constexpr (Epi::AFTER_DRAIN) { E.fused(acc, cur, wr, wc, fr, fq, lds, wid, lane); S.done(cur); }
#undef PG8_SA
#undef PG8_SB
#undef PG8_STAGE
#undef PG8_LDA
#undef PG8_LDB
#undef PG8_MMA
#undef PG8_WAIT_V
#undef PG8_WAIT_L
#undef PG8_BAR
#undef PG8_SCHED
}
}

#ifndef PG8_SP2
#define PG8_SP2 true
#endif
#ifndef PG8_ALIGN
#define PG8_ALIGN true
#endif
#ifndef REP_MASK
#define REP_MASK 0
#endif
#ifndef MK_MODE
#define MK_MODE 2
#endif

constexpr int D = 1024, NB = 16, SEQ = 4096, DSEQ = 16, NPROJ = 3200, NPAD = 3328;
constexpr int MP = NB * SEQ;
constexpr int MS = NB * DSEQ;
constexpr int MT = MP + MS;
constexpr int NPHASE = 10;
constexpr float EPS = 1e-6f;
constexpr int ZC_P = 0, ZC_ZP = 256, ZC_GB = 512, ZC_GC = 896, ZC_HX = 1280, ZC_ZC = 1664, ZC_U = 2048, ZC_V = 2432, ZC_ZG = 2816;
constexpr size_t OFF_YP = 0, OFF_YS = (size_t)MP * D, OFF_POOL_P = OFF_YS + (size_t)MS * D, OFF_CONV_P = OFF_POOL_P + 2 * 16 * 15 * 256,
                 OFF_POOL_S = OFF_CONV_P + 2 * 16 * 2 * 384, OFF_CONV_S = OFF_POOL_S + 2 * 16 * 15 * 256, OFF_V_S = OFF_CONV_S + 2 * 16 * 2 * 384;
constexpr size_t MiB = 1u << 20;
constexpr size_t WS_CTL = 0, CTL_ZERO_BYTES = 32768;
constexpr size_t WS_MOD = 1 * MiB;
constexpr size_t WS_WST = 2 * MiB;
constexpr size_t WS_WPT = 3 * MiB;
constexpr size_t WS_WOUT = 4 * MiB;
constexpr size_t WS_WIN = 8 * MiB;
constexpr size_t WIN_BYTES = (size_t)NPAD * D * 2;
constexpr size_t WS_H = 32 * MiB;
constexpr size_t WS_YC = 161 * MiB;
constexpr size_t WS_Z = 290 * MiB;
constexpr size_t WS_END = WS_Z + (size_t)MT * NPAD * 2;
static_assert(WS_WIN + 2 * WIN_BYTES <= WS_H && WS_H + (size_t)MT * D * 2 <= WS_YC && WS_YC + (size_t)MT * D * 2 <= WS_Z && WS_END <= 1024 * MiB, "d_ws map");

constexpr int NWAVES = 8;
constexpr int LDS_BYTES = 147456;

#define GAS __attribute__((address_space(1)))
#define CAS __attribute__((address_space(4)))
#define LAS __attribute__((address_space(3)))
typedef unsigned short bf16;
typedef unsigned v4u __attribute__((ext_vector_type(4)));
typedef unsigned v2u __attribute__((ext_vector_type(2)));
typedef float f32x4 __attribute__((ext_vector_type(4)));
typedef short bf16x8 __attribute__((ext_vector_type(8)));
#define LDS_WAIT() asm volatile("s_waitcnt lgkmcnt(0)" ::: "memory")

__device__ __forceinline__ unsigned f2bf(float f) { unsigned u = __builtin_bit_cast(unsigned, f); return (u + 0x7fffu + ((u >> 16) & 1u)) >> 16; }
__device__ __forceinline__ unsigned pk2(float lo, float hi) { return f2bf(lo) | (f2bf(hi) << 16); }
__device__ __forceinline__ float bf2f(unsigned v) { return __builtin_bit_cast(float, v << 16); }
__device__ __forceinline__ float silu_f(float x) { return x / (1.0f + __expf(-x)); }
__device__ __forceinline__ void unpack8(const v4u p, float (&f)[8]) {
    f[0] = __builtin_bit_cast(float, p.x << 16); f[1] = __builtin_bit_cast(float, p.x & 0xffff0000u);
    f[2] = __builtin_bit_cast(float, p.y << 16); f[3] = __builtin_bit_cast(float, p.y & 0xffff0000u);
    f[4] = __builtin_bit_cast(float, p.z << 16); f[5] = __builtin_bit_cast(float, p.z & 0xffff0000u);
    f[6] = __builtin_bit_cast(float, p.w << 16); f[7] = __builtin_bit_cast(float, p.w & 0xffff0000u); }
__device__ __forceinline__ v4u pack8(const float (&f)[8]) { v4u r; r.x = pk2(f[0], f[1]); r.y = pk2(f[2], f[3]); r.z = pk2(f[4], f[5]); r.w = pk2(f[6], f[7]); return r; }
__device__ __forceinline__ float wave_sum(float v) {
#pragma unroll
    for (int o = 1; o < 64; o <<= 1) v += __shfl_xor(v, o);
    return v;
}

struct Frame {
    LAS unsigned char* lds;
    int tid, lane, wave, vcu, G;
    const float *x_prompt, *x_sample, *state_pool, *state_conv, *c_prompt, *c_sample, *norm_g, *w_ada, *b_ada, *w_in, *w_pool, *pool_scale, *w_conv, *v_norm_g, *v_norm_b, *w_s, *b_s, *w_out, *final_g;
    float* out;
    float* mod; bf16 *WST, *WPT, *WOUT, *WIN, *H, *YC, *Z;
};

typedef GAS unsigned gu32;
#define RLX_AGENT __ATOMIC_RELAXED, __HIP_MEMORY_SCOPE_AGENT
constexpr int CW_BAR = 1024;
constexpr int MISC_OFF = 143360;
#define XB_TMO      128
#define XB_XCNT(j)  (256  + 64 * (j))
#define XB_XSUB(j)  (1280 + 64 * (j))
#define XB_XGEN(j)  (2304 + 64 * (j))
#define XB_TOP      3328
#define XB_TOPGEN   3392
#define XCD_BAR_WORDS 3456
#define XB_SPIN_CAP (1u << 18)

__device__ __forceinline__ unsigned xb_ld(unsigned* p)              { return __hip_atomic_load(p, __ATOMIC_RELAXED, __HIP_MEMORY_SCOPE_AGENT); }
__device__ __forceinline__ unsigned xb_add(unsigned* p, unsigned v) { return __hip_atomic_fetch_add(p, v, __ATOMIC_RELAXED, __HIP_MEMORY_SCOPE_AGENT); }
__device__ __forceinline__ unsigned xb_xcc_id() { return (unsigned)__builtin_amdgcn_s_getreg((3 << 11) | 20) & 0xFu; }
#define XB_SPIN(cond, bar) do { unsigned _sp = 0; while (cond) { __builtin_amdgcn_s_sleep(1); \
    if ((++_sp & 255u) == 0u) { if (xb_ld(&(bar)[XB_TMO])) break; if (_sp > XB_SPIN_CAP) { atomicAdd(&(bar)[XB_TMO], 1u); break; } } } } while (0)

struct XcdBarrier {
    unsigned* bar; unsigned x;
    volatile LAS unsigned* st;
};

__device__ __forceinline__ XcdBarrier xcd_barrier_post(unsigned* bar, volatile LAS unsigned* st) {
    XcdBarrier b; b.bar = bar; b.x = xb_xcc_id(); b.st = st;
    if (threadIdx.x == 0) (void)xb_add(&bar[XB_XCNT(b.x)], 1u);
    return b;
}
__device__ __forceinline__ void xcd_barrier_complete(unsigned* bar, unsigned x, unsigned& nloc, unsigned& nx) {
    const unsigned G = gridDim.x * gridDim.y * gridDim.z;
    unsigned sum, cnt, mine, sp = 0u;
    for (;;) {
        sum = 0u; cnt = 0u; mine = 0u;
#pragma unroll
        for (unsigned j = 0; j < 16; ++j) { const unsigned c = xb_ld(&bar[XB_XCNT(j)]); sum += c; cnt += (c > 0u) ? 1u : 0u; mine = (j == x) ? c : mine; }
        if (sum == G) break;
        __builtin_amdgcn_s_sleep(1);
        if ((++sp & 255u) == 0u) { if (xb_ld(&bar[XB_TMO])) break; if (sp > XB_SPIN_CAP) { atomicAdd(&bar[XB_TMO], 1u); break; } }
    }
    nloc = mine > 0u ? mine : 1u; nx = cnt > 0u ? cnt : 1u;
}

__device__ __forceinline__ void xcd_barrier(const XcdBarrier& b) {
    asm volatile("s_waitcnt vmcnt(0)" ::: "memory");
    __syncthreads();
    if (threadIdx.x == 0) {
        unsigned* bar = b.bar;
        __builtin_amdgcn_s_waitcnt(0);
        unsigned nloc = b.st[0], nx = b.st[1];
        if (nloc == 0u) { xcd_barrier_complete(bar, b.x, nloc, nx); b.st[0] = nloc; b.st[1] = nx; }
        const unsigned old = xb_add(&bar[XB_XSUB(b.x)], 1u);
        const unsigned gen = old / nloc;
        if (old + 1u == (gen + 1u) * nloc) {
            __builtin_amdgcn_fence(__ATOMIC_RELEASE, "agent");
            asm volatile("s_waitcnt vmcnt(0)" ::: "memory");
            const unsigned og = xb_add(&bar[XB_TOP], 1u);
            const unsigned tg = og / nx;
            if (og + 1u == (tg + 1u) * nx) xb_add(&bar[XB_TOPGEN], 1u);
            else XB_SPIN(xb_ld(&bar[XB_TOPGEN]) == tg, bar);
            __builtin_amdgcn_fence(__ATOMIC_ACQUIRE, "agent");
            xb_add(&bar[XB_XGEN(b.x)], 1u);
            asm volatile("s_waitcnt vmcnt(0)" ::: "memory");
        } else {
            XB_SPIN(xb_ld(&bar[XB_XGEN(b.x)]) == gen, bar);
            __builtin_amdgcn_fence(__ATOMIC_ACQUIRE, "agent");
            asm volatile("s_waitcnt vmcnt(0)" ::: "memory");
        }
    }
    __syncthreads();
}

__device__ __forceinline__ void p0_transpose_item(const float* W, int K, int N, bf16* WT, LAS float* scr, int item, int lane) {
    const int nblk = N / 32, kb = item / nblk, nb = item % nblk, k0 = 64 * kb, n0 = 32 * nb;
#pragma unroll 8
    for (int i = 0; i < 32; ++i) { const int kk = 2 * i + (lane >> 5); scr[kk * 33 + (lane & 31)] = W[(size_t)(k0 + kk) * N + n0 + (lane & 31)]; }
    LDS_WAIT(); asm volatile("" ::: "memory");
    const int c = lane & 7;
#pragma unroll
    for (int j = 0; j < 4; ++j) { const int n = (lane >> 3) + 8 * j; const LAS float* s = scr + (8 * c) * 33 + n;
        v4u o; o.x = pk2(s[0 * 33], s[1 * 33]); o.y = pk2(s[2 * 33], s[3 * 33]); o.z = pk2(s[4 * 33], s[5 * 33]); o.w = pk2(s[6 * 33], s[7 * 33]);
        *(GAS v4u*)(WT + (size_t)(n0 + n) * K + k0 + 8 * c) = o; }
    LDS_WAIT(); asm volatile("" ::: "memory");
}
__device__ __forceinline__ void p0_mod_item(const Frame& F, int item) {
    int tid = F.tid; asm volatile("" : "+v"(tid));
    const int lane = tid & 63, wave = __builtin_amdgcn_readfirstlane(tid >> 6);
    const int rh = item & 1, cb = (item >> 1) % 48, l = (item >> 1) / 48;
    LAS float* S = (LAS float*)F.lds;
    const float* cin = rh == 0 ? F.c_prompt : F.c_sample;
    {
        float cv[32];
#pragma unroll
        for (int i = 0; i < 32; ++i) cv[i] = cin[(tid & 15) * 1024 + (tid >> 4) + 32 * i];
        __builtin_amdgcn_sched_barrier(0);
#pragma unroll
        for (int i = 0; i < 32; ++i) S[tid + 512 * i] = silu_f(cv[i]);
    }
    __syncthreads();
    float acc[16];
#pragma unroll
    for (int r = 0; r < 16; ++r) acc[r] = 0.f;
    const float* wp = F.w_ada + (size_t)l * 1024 * 3072 + (size_t)(wave * 128) * 3072 + cb * 64 + lane;
#pragma unroll 1
    for (int kb = 0; kb < 8; ++kb) {
        float wv[16];
#pragma unroll
        for (int j = 0; j < 16; ++j) wv[j] = wp[(size_t)j * 3072];
        wp += 16 * 3072;
        __builtin_amdgcn_sched_barrier(0);
#pragma unroll
        for (int j = 0; j < 16; ++j) { const LAS f32x4* sp = (const LAS f32x4*)(S + (wave * 128 + kb * 16 + j) * 16);
#pragma unroll
            for (int q = 0; q < 4; ++q) { const f32x4 s = sp[q]; acc[4 * q + 0] += s.x * wv[j]; acc[4 * q + 1] += s.y * wv[j]; acc[4 * q + 2] += s.z * wv[j]; acc[4 * q + 3] += s.w * wv[j]; }
            if ((j & 3) == 3) __builtin_amdgcn_sched_barrier(0); }
    }
    __syncthreads();
    LAS float* red = (LAS float*)F.lds;
#pragma unroll
    for (int r = 0; r < 16; ++r) red[(wave * 16 + r) * 64 + lane] = acc[r];
    __syncthreads();
    for (int o = tid; o < 1024; o += 512) { const int r = o >> 6, ln = o & 63; float s = 0.f;
#pragma unroll
        for (int w = 0; w < 8; ++w) s += red[(w * 16 + r) * 64 + ln];
        F.mod[((size_t)l * 32 + rh * 16 + r) * 3072 + cb * 64 + ln] = s + F.b_ada[l * 3072 + cb * 64 + ln]; }
    __syncthreads();
}
__device__ __forceinline__ void p0_prologue(const Frame& F) {
    for (int it = F.vcu; it < 192; it += F.G) p0_mod_item(F, it);
}
__device__ __forceinline__ void prep_weights(const Frame& F) {
    LAS float* scr = (LAS float*)(F.lds + F.wave * 16384);
    const int gw = F.vcu * NWAVES + F.wave, NGW = F.G * NWAVES;
    constexpr int I_IN = (D / 64) * (NPROJ / 32), I_OUT = (D / 64) * (D / 32);
    for (int it = gw; it < 2 * I_IN + 2 * I_OUT; it += NGW) {
        int r = it;
        if (r < 2 * I_IN) { const int l = r / I_IN; r -= l * I_IN; p0_transpose_item(F.w_in + (size_t)l * D * NPROJ, D, NPROJ, F.WIN + (size_t)l * NPAD * D, scr, r, F.lane); }
        else { r -= 2 * I_IN; const int l = r / I_OUT; r -= l * I_OUT; p0_transpose_item(F.w_out + (size_t)l * D * D, D, D, F.WOUT + (size_t)l * D * D, scr, r, F.lane); }
    }
    const int gt = F.vcu * 512 + F.tid, NGT = F.G * 512;
    for (int i = gt; i < 2 * (NPAD - NPROJ) * D / 8; i += NGT) {
        const int l = i / ((NPAD - NPROJ) * D / 8), j = i % ((NPAD - NPROJ) * D / 8);
        *(GAS v4u*)(F.WIN + (size_t)l * NPAD * D + (size_t)NPROJ * D + (size_t)j * 8) = (v4u){0u, 0u, 0u, 0u}; }
    for (int i = gt; i < 2 * 6 * 128 * 128; i += NGT) {
        const int s = i & 127, t = (i >> 7) & 127; F.WST[i] = (bf16)(((s >> 6) <= (t >> 6)) ? f2bf(F.w_s[i]) : 0u); }
    for (int i = gt; i < 2 * 4 * 64 * 64; i += NGT) {
        const int d = i & 63, e = (i >> 6) & 63, lg = i >> 12; F.WPT[i] = (bf16)f2bf(F.w_pool[(lg * 64 + d) * 64 + e]); }
}

__device__ __forceinline__ void norm_phase(const Frame& F, int l) {
    const int gw = F.vcu * NWAVES + F.wave, NGW = F.G * NWAVES;
    const float* modl = F.mod + (size_t)l * 32 * 3072; const float* ng = F.norm_g + l * 1024;
    for (int row = gw; row < MT; row += NGW) {
        const float* xr; int r;
        if (row < MP) { xr = (l == 0 ? F.x_prompt : F.out) + (size_t)row * D; r = row >> 12; }
        else { xr = (l == 0 ? F.x_sample + (size_t)(row - MP) * D : F.out + (size_t)row * D); r = 16 + ((row - MP) >> 4); }
        const GAS f32x4* xp = (const GAS f32x4*)xr + F.lane;
        f32x4 v[4]; float ss = 0.f;
#pragma unroll
        for (int j = 0; j < 4; ++j) { v[j] = xp[64 * j]; ss += (v[j].x * v[j].x + v[j].y * v[j].y) + (v[j].z * v[j].z + v[j].w * v[j].w); }
        const float rstd = 1.0f / sqrtf(wave_sum(ss) * (1.0f / D) + EPS);
        const float* mr = modl + (size_t)r * 3072;
        GAS v2u* o8 = (GAS v2u*)(F.H + (size_t)row * D) + F.lane;
#pragma unroll
        for (int j = 0; j < 4; ++j) { const int col = 4 * F.lane + 256 * j;
            const f32x4 g = *(const f32x4*)(ng + col), sh = *(const f32x4*)(mr + col), sc = *(const f32x4*)(mr + 1024 + col);
            const f32x4 y = (v[j] * rstd * g) * (sc + 1.0f) + sh;
            v2u w; w.x = pk2(y.x, y.y); w.y = pk2(y.z, y.w); o8[64 * j] = w; }
    }
}
__device__ __forceinline__ void final_norm_phase(const Frame& F) {
    const int gw = F.vcu * NWAVES + F.wave, NGW = F.G * NWAVES;
    for (int row = gw; row < MT; row += NGW) {
        GAS f32x4* xp = (GAS f32x4*)(F.out + (size_t)row * D) + F.lane;
        f32x4 v[4]; float ss = 0.f;
#pragma unroll
        for (int j = 0; j < 4; ++j) { v[j] = xp[64 * j]; ss += (v[j].x * v[j].x + v[j].y * v[j].y) + (v[j].z * v[j].z + v[j].w * v[j].w); }
        const float rstd = 1.0f / sqrtf(wave_sum(ss) * (1.0f / D) + EPS);
#pragma unroll
        for (int j = 0; j < 4; ++j) { const f32x4 g = *(const f32x4*)(F.final_g + 4 * F.lane + 256 * j); xp[64 * j] = v[j] * rstd * g; }
    }
}

constexpr int PB_OFF = 0, DM_OFF = 73728, DM_PITCH = 528, VN_PITCH = 272;
#define SCHED_FENCE() __builtin_amdgcn_sched_barrier(0)
__device__ __forceinline__ float sum16(float v) {
#pragma unroll
    for (int o = 1; o < 16; o <<= 1) v += __shfl_xor(v, o);
    return v;
}
__device__ __forceinline__ void mixer_tile(const Frame& F, int l, int ti) {
    int tid = F.tid; asm volatile("" : "+v"(tid));
    const int lane = tid & 63;
    const bool samp = ti >= 512;
    const int b = samp ? ti - 512 : ti >> 5, c = samp ? 0 : ti & 31;
    const int nTok = samp ? 16 : 128;
    const size_t row0 = samp ? (size_t)MP + b * 16 : (size_t)b * SEQ + c * 128;
    const int pos0 = samp ? 1024 : c * 128;
    const bf16* Zt = F.Z + row0 * NPAD;
    bf16* Yt = F.YC + row0 * D;
    LAS bf16* pbuf = (LAS bf16*)(F.lds + PB_OFF);
    LAS unsigned char* dmat = F.lds + DM_OFF;
    const int fr = lane & 15, fq = lane >> 4;
    const bool zhist = !samp && c > 0;
    {
        v4u val[8];
#pragma unroll
        for (int i = 0; i < 8; ++i) { const int idx = tid + 512 * i; val[i] = (v4u){0u, 0u, 0u, 0u};
            if (idx < nTok * 32) val[i] = *(const GAS v4u*)(Zt + (size_t)(idx >> 5) * NPAD + ZC_P + (idx & 31) * 8); }
        v4u hv = (v4u){0u, 0u, 0u, 0u};
        if (tid < 480) { const int r = tid >> 5, ch8 = (tid & 31) * 8;
            if (zhist) hv = *(const GAS v4u*)(Zt + (ptrdiff_t)(r - 15) * NPAD + ZC_P + ch8);
            else if (samp) { const float* sp = F.state_pool + ((size_t)(l * 16 + b) * 15 + r) * 256 + ch8; const f32x4 a = *(const f32x4*)sp, bb = *(const f32x4*)(sp + 4);
                hv.x = pk2(a.x, a.y); hv.y = pk2(a.z, a.w); hv.z = pk2(bb.x, bb.y); hv.w = pk2(bb.z, bb.w); } }
        SCHED_FENCE();
#pragma unroll
        for (int i = 0; i < 8; ++i) { const int idx = tid + 512 * i; if (idx < nTok * 32) *(LAS v4u*)(pbuf + 15 * 256 + idx * 8) = val[i]; }
        if (tid < 480) *(LAS v4u*)(pbuf + tid * 8) = hv;
    }
    __syncthreads();
    {
        const int ch = tid & 255, seg = tid >> 8, g = ch >> 6, w = 2 << g;
        const int t0 = seg * 64, len = samp ? (seg == 0 ? 16 : 0) : 64;
        if (len > 0) {
            float S = 0.f;
            for (int i = 1; i < w; ++i) S += bf2f(pbuf[(15 + t0 - i) * 256 + ch]);
#pragma unroll 8
            for (int t = t0; t < t0 + len; ++t) {
                const float pv = bf2f(pbuf[(15 + t) * 256 + ch]);
                S += pv;
                const int pc = pos0 + t + 1; const float cnt = (float)(pc < w ? pc : w);
                const float dv = S / cnt - pv;
                *(LAS bf16*)(dmat + t * DM_PITCH + ch * 2) = (bf16)f2bf(dv);
                S -= bf2f(pbuf[(15 + t - w + 1) * 256 + ch]);
            }
        }
    }
    __syncthreads();
    if (F.wave * 16 < nTok) {
        const int t = F.wave * 16 + fr;
        const bf16* zr = Zt + (size_t)t * NPAD; bf16* yr = Yt + (size_t)t * D;
        const bf16* WpT = F.WPT + l * 16384; const float* ps = F.pool_scale + l * 256;
        v4u zp[4][2];
#pragma unroll
        for (int g = 0; g < 4; ++g)
#pragma unroll
            for (int hh = 0; hh < 2; ++hh) zp[g][hh] = *(const GAS v4u*)(zr + ZC_ZP + g * 64 + 32 * hh + 8 * fq);
        SCHED_FENCE();
#pragma unroll
        for (int g = 0; g < 4; ++g) {
            bf16x8 bfr[2], afr[4][2]; f32x4 sc[2][2];
#pragma unroll
            for (int et = 0; et < 4; ++et) { const int e = 32 * (et >> 1) + 8 * (fr >> 2) + 4 * (et & 1) + (fr & 3);
#pragma unroll
                for (int kk = 0; kk < 2; ++kk) afr[et][kk] = *(const GAS bf16x8*)(WpT + (g * 64 + e) * 64 + 32 * kk + 8 * fq); }
#pragma unroll
            for (int hh = 0; hh < 2; ++hh) { sc[hh][0] = *(const f32x4*)(ps + g * 64 + 32 * hh + 8 * fq); sc[hh][1] = *(const f32x4*)(ps + g * 64 + 32 * hh + 8 * fq + 4); }
#pragma unroll
            for (int kk = 0; kk < 2; ++kk) bfr[kk] = *(const LAS bf16x8*)(dmat + t * DM_PITCH + (g * 64 + 32 * kk + 8 * fq) * 2);
            SCHED_FENCE();
            f32x4 acc[4];
#pragma unroll
            for (int et = 0; et < 4; ++et) { acc[et] = (f32x4){0.f, 0.f, 0.f, 0.f};
#pragma unroll
                for (int kk = 0; kk < 2; ++kk) acc[et] = __builtin_amdgcn_mfma_f32_16x16x32_bf16(afr[et][kk], bfr[kk], acc[et], 0, 0, 0); }
#pragma unroll
            for (int hh = 0; hh < 2; ++hh) { const int ch = g * 64 + 32 * hh + 8 * fq;
                float zv[8], o[8]; unpack8(zp[g][hh], zv);
#pragma unroll
                for (int i = 0; i < 4; ++i) { o[i] = acc[2 * hh][i] * sc[hh][0][i] * silu_f(zv[i]); o[4 + i] = acc[2 * hh + 1][i] * sc[hh][1][i] * silu_f(zv[4 + i]); }
                *(GAS v4u*)(yr + ch) = pack8(o); }
            SCHED_FENCE();
        }
    }
    if (samp || c == 31) {
        float* dst = F.out + (samp ? OFF_POOL_S : OFF_POOL_P) + (size_t)(l * 16 + b) * 15 * 256;
        const int rbase = samp ? 16 : 128;
        for (int idx = tid; idx < 15 * 256; idx += 512) dst[idx] = bf2f(pbuf[rbase * 256 + idx]);
    }
    __syncthreads();
    LAS unsigned char* vnT = F.lds;
    if (samp) for (int idx = tid; idx < 768; idx += 512) *(LAS v4u*)(vnT + (idx >> 1) * VN_PITCH + 32 + (idx & 1) * 16) = (v4u){0u, 0u, 0u, 0u};
    if (F.wave * 16 < nTok) {
        const int tb = F.wave * 16 + 4 * fq;
        v4u raw[4][3];
#pragma unroll
        for (int it = 0; it < 4; ++it)
#pragma unroll
            for (int j = 0; j < 3; ++j) raw[it][j] = *(const GAS v4u*)(Zt + (size_t)(tb + it) * NPAD + ZC_V + (fr + 16 * j) * 8);
        SCHED_FENCE();
#pragma unroll
        for (int pp = 0; pp < 2; ++pp) {
            float x[2][24]; float s1[2], s2[2];
#pragma unroll
            for (int e2 = 0; e2 < 2; ++e2) { s1[e2] = 0.f; s2[e2] = 0.f;
#pragma unroll
                for (int j = 0; j < 3; ++j) { float f[8]; unpack8(raw[2 * pp + e2][j], f);
#pragma unroll
                    for (int e = 0; e < 8; ++e) { x[e2][8 * j + e] = f[e]; s1[e2] += f[e]; s2[e2] += f[e] * f[e]; } } }
#pragma unroll
            for (int e2 = 0; e2 < 2; ++e2) { s1[e2] = sum16(s1[e2]); s2[e2] = sum16(s2[e2]); }
            float mu[2], rs[2];
#pragma unroll
            for (int e2 = 0; e2 < 2; ++e2) { mu[e2] = s1[e2] * (1.0f / 384.0f); const float var = fmaxf(s2[e2] * (1.0f / 384.0f) - mu[e2] * mu[e2], 0.f); rs[e2] = 1.0f / sqrtf(var + EPS); }
#pragma unroll
            for (int j = 0; j < 3; ++j) {
                const float* gp = F.v_norm_g + l * 384 + (fr + 16 * j) * 8; const float* bp = F.v_norm_b + l * 384 + (fr + 16 * j) * 8;
                const f32x4 g0 = *(const f32x4*)gp, g1 = *(const f32x4*)(gp + 4), b0 = *(const f32x4*)bp, b1 = *(const f32x4*)(bp + 4);
#pragma unroll
                for (int e = 0; e < 8; ++e) { const int k = 8 * j + e, cc = (fr + 16 * j) * 8 + e;
                    const float gmk = e < 4 ? g0[e & 3] : g1[e & 3], bek = e < 4 ? b0[e & 3] : b1[e & 3];
                    const float y0 = (x[0][k] - mu[0]) * rs[0] * gmk + bek, y1 = (x[1][k] - mu[1]) * rs[1] * gmk + bek;
                    x[0][k] = y0; x[1][k] = y1;
                    *(LAS unsigned*)(vnT + cc * VN_PITCH + (tb + 2 * pp) * 2) = pk2(y0, y1); } }
            SCHED_FENCE();
            if (samp) {
#pragma unroll
                for (int e2 = 0; e2 < 2; ++e2) { float* vo = F.out + OFF_V_S + ((size_t)(l * 16 + b) * 16 + tb + 2 * pp + e2) * 384;
#pragma unroll
                    for (int j = 0; j < 3; ++j) { float* vp = vo + (fr + 16 * j) * 8;
                        *(f32x4*)vp = (f32x4){x[e2][8 * j], x[e2][8 * j + 1], x[e2][8 * j + 2], x[e2][8 * j + 3]};
                        *(f32x4*)(vp + 4) = (f32x4){x[e2][8 * j + 4], x[e2][8 * j + 5], x[e2][8 * j + 6], x[e2][8 * j + 7]}; } }
            }
        }
    }
    __syncthreads();
    if (F.wave * 16 < nTok) {
        const int t = F.wave * 16 + fr; const int nk = samp ? 1 : 4;
        const bf16* zr = Zt + (size_t)t * NPAD; bf16* yr = Yt + (size_t)t * D;
        const bf16* Wl = F.WST + (size_t)l * 6 * 16384;
        bf16x8 wfr[2][4]; v4u up[2][2], zg[2][2]; float bsv[2];
#define GM_LOAD(h, s) do { _Pragma("unroll") for (int kk = 0; kk < 4; ++kk) wfr[s][kk] = (kk < nk) ? *(const GAS bf16x8*)(Wl + (size_t)((h) * 128 + t) * 128 + 32 * kk + 8 * fq) : (bf16x8){0, 0, 0, 0, 0, 0, 0, 0}; \
        _Pragma("unroll") for (int hh = 0; hh < 2; ++hh) { up[s][hh] = *(const GAS v4u*)(zr + ZC_U + (h) * 64 + 32 * hh + 8 * fq); zg[s][hh] = *(const GAS v4u*)(zr + ZC_ZG + (h) * 64 + 32 * hh + 8 * fq); } \
        bsv[s] = F.b_s[(l * 6 + (h)) * 128 + t]; } while (0)
        GM_LOAD(0, 0);
#pragma unroll
        for (int h = 0; h < 6; ++h) {
            const int s = h & 1;
            if (h + 1 < 6) GM_LOAD(h + 1, s ^ 1);
            SCHED_FENCE();
            f32x4 acc[4];
#pragma unroll
            for (int ct = 0; ct < 4; ++ct) { const int chrow = h * 64 + 32 * (ct >> 1) + 8 * (fr >> 2) + 4 * (ct & 1) + (fr & 3);
                acc[ct] = (f32x4){0.f, 0.f, 0.f, 0.f};
#pragma unroll
                for (int kk = 0; kk < 4; ++kk) if (kk < nk) { const bf16x8 a = *(const LAS bf16x8*)(vnT + chrow * VN_PITCH + (32 * kk + 8 * fq) * 2);
                    acc[ct] = __builtin_amdgcn_mfma_f32_16x16x32_bf16(a, wfr[s][kk], acc[ct], 0, 0, 0); } }
#pragma unroll
            for (int hh = 0; hh < 2; ++hh) { const int ch = h * 64 + 32 * hh + 8 * fq;
                float uv[8], zv[8], o[8]; unpack8(up[s][hh], uv); unpack8(zg[s][hh], zv);
#pragma unroll
                for (int i = 0; i < 4; ++i) { o[i] = uv[i] * (acc[2 * hh][i] + bsv[s]) * silu_f(zv[i]); o[4 + i] = uv[4 + i] * (acc[2 * hh + 1][i] + bsv[s]) * silu_f(zv[4 + i]); }
                *(GAS v4u*)(yr + 640 + ch) = pack8(o); }
            SCHED_FENCE();
        }
#undef GM_LOAD
    }
    {
        const int nItems = 48 * (nTok >> 2);
        float* cdst = F.out + (samp ? OFF_CONV_S : OFF_CONV_P) + (size_t)(l * 16 + b) * 2 * 384;
#pragma unroll 1
        for (int it = tid; it < nItems; it += 512) {
            const int chunk = it % 48, tg = it / 48, ch = chunk * 8, t0 = tg * 4;
            const bool hz = tg > 0 || zhist;
            v4u gcr[6], hxr[6], gbr[4], zcr[4];
#pragma unroll
            for (int r = 0; r < 6; ++r) { gcr[r] = (v4u){0u, 0u, 0u, 0u}; hxr[r] = (v4u){0u, 0u, 0u, 0u};
                if (r >= 2 || hz) { const bf16* zr = Zt + (ptrdiff_t)(t0 - 2 + r) * NPAD; gcr[r] = *(const GAS v4u*)(zr + ZC_GC + ch); hxr[r] = *(const GAS v4u*)(zr + ZC_HX + ch); } }
#pragma unroll
            for (int r = 0; r < 4; ++r) { const bf16* zr = Zt + (size_t)(t0 + r) * NPAD; gbr[r] = *(const GAS v4u*)(zr + ZC_GB + ch); zcr[r] = *(const GAS v4u*)(zr + ZC_ZC + ch); }
            float w0[8], w1[8], w2[8];
            { const float* wc = F.w_conv + l * 3 * 384 + ch;
#pragma unroll
              for (int k = 0; k < 2; ++k) { const f32x4 a = *(const f32x4*)(wc + 4 * k), bq = *(const f32x4*)(wc + 384 + 4 * k), cq = *(const f32x4*)(wc + 768 + 4 * k);
#pragma unroll
                  for (int e = 0; e < 4; ++e) { w0[4 * k + e] = a[e]; w1[4 * k + e] = bq[e]; w2[4 * k + e] = cq[e]; } } }
            float q[6][8];
            if (!hz && samp) { const float* sp = F.state_conv + (size_t)(l * 16 + b) * 2 * 384 + ch;
#pragma unroll
                for (int k = 0; k < 2; ++k) { const f32x4 a = *(const f32x4*)(sp + 4 * k), bq = *(const f32x4*)(sp + 384 + 4 * k);
#pragma unroll
                    for (int e = 0; e < 4; ++e) { q[0][4 * k + e] = a[e]; q[1][4 * k + e] = bq[e]; } } }
            SCHED_FENCE();
#pragma unroll
            for (int r = 0; r < 6; ++r) { if (r >= 2 || hz || !samp) { float a[8], bq[8]; unpack8(gcr[r], a); unpack8(hxr[r], bq);
#pragma unroll
                for (int e = 0; e < 8; ++e) q[r][e] = a[e] * bq[e]; } }
#pragma unroll
            for (int r = 0; r < 4; ++r) { float gb[8], zc[8], o[8]; unpack8(gbr[r], gb); unpack8(zcr[r], zc);
#pragma unroll
                for (int e = 0; e < 8; ++e) o[e] = gb[e] * (w0[e] * q[r][e] + w1[e] * q[r + 1][e] + w2[e] * q[r + 2][e]) * silu_f(zc[e]);
                *(GAS v4u*)(Yt + (size_t)(t0 + r) * D + 256 + ch) = pack8(o); }
            if (t0 + 4 == nTok && (samp || c == 31)) {
#pragma unroll
                for (int r = 0; r < 2; ++r) { float* dp = cdst + r * 384 + ch;
                    *(f32x4*)dp = (f32x4){q[4 + r][0], q[4 + r][1], q[4 + r][2], q[4 + r][3]}; *(f32x4*)(dp + 4) = (f32x4){q[4 + r][4], q[4 + r][5], q[4 + r][6], q[4 + r][7]}; } }
        }
    }
    __syncthreads();
}
__device__ __forceinline__ void mixer_phase(const Frame& F, int l) {
    for (int ti = F.vcu; ti < 512 + 16; ti += F.G) mixer_tile(F, l, ti);
}

template <int MODE>
__device__ __forceinline__ void skinny_item(const Frame& F, int l, int item) {
    const int fr = F.lane & 15, fq = F.lane >> 4, n0 = item * 16;
    const bf16* A = (MODE == 0 ? F.H : F.YC) + (size_t)MP * D;
    const bf16* Bt = MODE == 0 ? F.WIN + (size_t)l * NPAD * D : F.WOUT + (size_t)l * D * D;
    const bf16* brow = Bt + (size_t)(n0 + fr) * D + 8 * fq;
    const bf16* arow = A + (size_t)(32 * F.wave + fr) * D + 8 * fq;
    f32x4 acc0 = (f32x4){0.f, 0.f, 0.f, 0.f}, acc1 = acc0;
#pragma unroll 1
    for (int kc = 0; kc < 4; ++kc) {
        bf16x8 wv[8], a0[8], a1[8];
#pragma unroll
        for (int j = 0; j < 8; ++j) { const int ko = (kc * 8 + j) * 32; wv[j] = *(const GAS bf16x8*)(brow + ko); a0[j] = *(const GAS bf16x8*)(arow + ko); a1[j] = *(const GAS bf16x8*)(arow + 16 * D + ko); }
        __builtin_amdgcn_sched_barrier(0);
#pragma unroll
        for (int j = 0; j < 8; ++j) { acc0 = __builtin_amdgcn_mfma_f32_16x16x32_bf16(wv[j], a0[j], acc0, 0, 0, 0); acc1 = __builtin_amdgcn_mfma_f32_16x16x32_bf16(wv[j], a1[j], acc1, 0, 0, 0); }
        __builtin_amdgcn_sched_barrier(0);
    }
#pragma unroll
    for (int tt = 0; tt < 2; ++tt) {
        const f32x4 a = tt == 0 ? acc0 : acc1; const int t = 32 * F.wave + 16 * tt + fr, nn = n0 + 4 * fq;
        if (MODE == 0) { v2u w; w.x = pk2(a.x, a.y); w.y = pk2(a.z, a.w); *(GAS v2u*)(F.Z + (size_t)(MP + t) * NPAD + nn) = w; }
        else { const float* bp = (l == 0 ? F.x_sample : F.out + (size_t)MP * D) + (size_t)t * D + nn;
            const f32x4 g = *(const f32x4*)(F.mod + ((size_t)l * 32 + 16 + (t >> 4)) * 3072 + 2048 + nn), b = *(const f32x4*)bp;
            *(f32x4*)(F.out + (size_t)(MP + t) * D + nn) = b + g * a; }
    }
}
template <int MODE>
__device__ __forceinline__ void skinny_phase(const Frame& F, int l) {
    const int nitems = MODE == 0 ? NPROJ / 16 : D / 16;
    for (int it = F.vcu; it < nitems; it += F.G) skinny_item<MODE>(F, l, it);
}

struct Args { const float* in[19]; float* out; unsigned char* ws; int ph_lo, ph_hi; };
__global__ void __launch_bounds__(NWAVES * 64, 2) fwd(Args args) {
    extern __shared__ __attribute__((aligned(16))) unsigned char lds_raw[];
    const int lo = args.ph_lo, hi = args.ph_hi;
#define MAKE_FRAME() Frame F; { int tid_ = threadIdx.x; asm volatile("" : "+v"(tid_)); const CAS Args* ap = (const CAS Args*)__builtin_amdgcn_kernarg_segment_ptr(); asm volatile("" : "+s"(ap)); \
    F.lds = (LAS unsigned char*)lds_raw; F.tid = tid_; F.lane = F.tid & 63; F.wave = __builtin_amdgcn_readfirstlane(F.tid >> 6); \
    F.G = gridDim.x; { const int bx = blockIdx.x; F.vcu = (F.G % 8 == 0) ? (bx % 8) * (F.G / 8) + bx / 8 : bx; } \
    F.x_prompt = ap->in[0]; F.x_sample = ap->in[1]; F.state_pool = ap->in[2]; F.state_conv = ap->in[3]; F.c_prompt = ap->in[4]; F.c_sample = ap->in[5]; \
    F.norm_g = ap->in[6]; F.w_ada = ap->in[7]; F.b_ada = ap->in[8]; F.w_in = ap->in[9]; F.w_pool = ap->in[10]; F.pool_scale = ap->in[11]; F.w_conv = ap->in[12]; \
    F.v_norm_g = ap->in[13]; F.v_norm_b = ap->in[14]; F.w_s = ap->in[15]; F.b_s = ap->in[16]; F.w_out = ap->in[17]; F.final_g = ap->in[18]; \
    F.out = ap->out; unsigned char* ws = ap->ws; \
    F.mod = (float*)(ws + WS_MOD); F.WST = (bf16*)(ws + WS_WST); F.WPT = (bf16*)(ws + WS_WPT); F.WOUT = (bf16*)(ws + WS_WOUT); F.WIN = (bf16*)(ws + WS_WIN); \
    F.H = (bf16*)(ws + WS_H); F.YC = (bf16*)(ws + WS_YC); F.Z = (bf16*)(ws + WS_Z); }
#if MK_MODE == 1
    cg::grid_group grid = cg::this_grid();
#define GRID_BAR() grid.sync()
#elif MK_MODE == 2
    if (threadIdx.x < 2) ((LAS unsigned*)(lds_raw + MISC_OFF))[threadIdx.x] = 0u;
    __syncthreads();
    if (hi - lo > 1) { const CAS Args* ap0 = (const CAS Args*)__builtin_amdgcn_kernarg_segment_ptr(); (void)xcd_barrier_post((unsigned*)(ap0->ws + WS_CTL) + CW_BAR, (volatile LAS unsigned*)(lds_raw + MISC_OFF)); }
#define GRID_BAR() do { const CAS Args* apb = (const CAS Args*)__builtin_amdgcn_kernarg_segment_ptr(); asm volatile("" : "+s"(apb)); XcdBarrier xb_; xb_.bar = (unsigned*)(apb->ws + WS_CTL) + CW_BAR; xb_.x = xb_xcc_id(); \
    xb_.st = (volatile LAS unsigned*)(lds_raw + MISC_OFF); xcd_barrier(xb_); } while (0)
#else
#define GRID_BAR() do {} while (0)
#endif
#define IN(k) (lo <= (k) && (k) < hi)
#define SEAM(k) do { if (IN(k) && IN((k) + 1)) GRID_BAR(); } while (0)

#define REPS(k) (1 + ((REP_MASK >> (k)) & 1))
#define PH_START(k) TEL_DECL; TEL_START(101 + 2 * (k), threadIdx.x == 0)
#define PH_STOP(k) do { const CAS Args* apq_ = (const CAS Args*)__builtin_amdgcn_kernarg_segment_ptr(); TEL_STOP(101 + 2 * (k), threadIdx.x == 0, apq_->ws + TEL_WORD_OFF); } while (0)
    if (IN(0)) { PH_START(0);
#pragma unroll 1
        for (int rp = 0; rp < REPS(0); ++rp) { MAKE_FRAME(); p0_prologue(F); if (rp + 1 < REPS(0)) GRID_BAR(); }
        SEAM(0); PH_STOP(0); }
#pragma unroll 1
    for (int l = 0; l < 2; ++l) {
        const int pb = 1 + 4 * l;
        if (IN(pb)) { PH_START(pb);
#pragma unroll 1
            for (int rp = 0; rp < REPS(pb); ++rp) { MAKE_FRAME(); if (l == 0) prep_weights(F); norm_phase(F, l); if (rp + 1 < REPS(pb)) GRID_BAR(); }
            SEAM(pb); PH_STOP(pb); }
        if (IN(pb + 1)) { PH_START(pb + 1);
#pragma unroll 1
            for (int rp = 0; rp < REPS(pb + 1); ++rp) {
            MAKE_FRAME(); skinny_phase<0>(F, l);
            pg8::Gemm g{F.H, F.WIN + (size_t)l * NPAD * D, MP, NPAD, D}; pg8::StaticOrder S; S.init(MP, NPAD, F.G, (int)blockIdx.x);
            pg8::EpiZ E{F.Z, NPAD};
            TEL_DECL; TEL_START(5, threadIdx.x == 0);
            pg8::gemm_phase<pg8::EpiZ, pg8::StaticOrder, PG8_ALIGN, PG8_SP2>(F.lds, g, S, E, (unsigned char*)F.mod - WS_MOD + TEL_WORD_OFF);
            TEL_STOP(5, threadIdx.x == 0, (unsigned char*)F.mod - WS_MOD + TEL_WORD_OFF);
            if (rp + 1 < REPS(pb + 1)) GRID_BAR(); }
            { TEL_DECL; TEL_START(7, threadIdx.x == 0); SEAM(pb + 1); const CAS Args* apq = (const CAS Args*)__builtin_amdgcn_kernarg_segment_ptr(); TEL_STOP(7, threadIdx.x == 0, apq->ws + TEL_WORD_OFF); }
            PH_STOP(pb + 1);
        }
        if (IN(pb + 2)) { PH_START(pb + 2);
#pragma unroll 1
            for (int rp = 0; rp < REPS(pb + 2); ++rp) { MAKE_FRAME(); mixer_phase(F, l); if (rp + 1 < REPS(pb + 2)) GRID_BAR(); }
            SEAM(pb + 2); PH_STOP(pb + 2); }
        if (IN(pb + 3)) { PH_START(pb + 3);
#pragma unroll 1
            for (int rp = 0; rp < REPS(pb + 3); ++rp) {
            MAKE_FRAME(); skinny_phase<1>(F, l);
            pg8::Gemm g{F.YC, F.WOUT + (size_t)l * D * D, MP, D, D}; pg8::StaticOrder S; S.init(MP, D, F.G, (int)blockIdx.x);
            pg8::EpiRes E{l == 0 ? F.x_prompt : F.out, F.out, F.mod + (size_t)l * 32 * 3072 + 2048};
            pg8::gemm_phase<pg8::EpiRes, pg8::StaticOrder, PG8_ALIGN, PG8_SP2>(F.lds, g, S, E, (unsigned char*)F.mod - WS_MOD + TEL_WORD_OFF);
            if (rp + 1 < REPS(pb + 3)) GRID_BAR(); }
            SEAM(pb + 3); PH_STOP(pb + 3);
        }
    }
    if (IN(9)) { PH_START(9); MAKE_FRAME(); final_norm_phase(F); PH_STOP(9); }
#if TELEM
    if (blockIdx.x == TEL_WG && threadIdx.x == 0 && hi == NPHASE) {
        const CAS Args* apt = (const CAS Args*)__builtin_amdgcn_kernarg_segment_ptr();
        const unsigned long long v = __hip_atomic_load((unsigned long long*)(apt->ws + TEL_WORD_OFF), __ATOMIC_RELAXED, __HIP_MEMORY_SCOPE_AGENT);
        const unsigned long long want = (TELEM & 1) ? v * 4ull : v / 50ull;
        const unsigned long long t0 = __builtin_amdgcn_s_memrealtime();
        while ((unsigned long long)__builtin_amdgcn_s_memrealtime() - t0 < want) __builtin_amdgcn_s_sleep(8);
    }
#endif
#undef IN
#undef SEAM
}

extern "C" void kernel_launch(void* const* d_in, const int* in_sizes, int n_in, void* d_out, int out_size, void* d_ws, size_t ws_size, hipStream_t stream) {
    static int grid = 0;
    if (grid == 0) {
        if (n_in != 19 || ws_size < WS_END) { fprintf(stderr, "kernel_launch: expected 19 inputs and >= %zu bytes of workspace; got n_in %d, ws %zu\n", (size_t)WS_END, n_in, ws_size); grid = -1; return; }
        int dev = 0, cus = 0, per_cu = 0;
        if (hipGetDevice(&dev) != hipSuccess || hipDeviceGetAttribute(&cus, hipDeviceAttributeMultiprocessorCount, dev) != hipSuccess) { grid = -1; return; }
        if (hipFuncSetAttribute((const void*)fwd, hipFuncAttributeMaxDynamicSharedMemorySize, LDS_BYTES) != hipSuccess) { fprintf(stderr, "kernel_launch: hipFuncSetAttribute failed\n"); grid = -1; return; }
        if (hipOccupancyMaxActiveBlocksPerMultiprocessor(&per_cu, (const void*)fwd, NWAVES * 64, LDS_BYTES) != hipSuccess || per_cu < 1) { fprintf(stderr, "kernel_launch: occupancy query says %d blocks per CU\n", per_cu); (void)hipGetLastError(); per_cu = 1; }
        grid = cus;
    }
    if (grid < 0) return;
    (void)hipMemsetAsync((char*)d_ws + WS_CTL, 0, CTL_ZERO_BYTES, stream);
    Args a{};
    for (int i = 0; i < 19; ++i) a.in[i] = (const float*)d_in[i];
    a.out = (float*)d_out; a.ws = (unsigned char*)d_ws;
#if MK_MODE == 2
    a.ph_lo = 0; a.ph_hi = NPHASE;
    hipLaunchKernelGGL(fwd, dim3(grid), dim3(NWAVES * 64), LDS_BYTES, stream, a);
    { const hipError_t le = hipPeekAtLastError(); if (le != hipSuccess) fprintf(stderr, "kernel_launch: launch failed: %s\n", hipGetErrorName(le)); }
#elif MK_MODE == 0
    for (int ph = 0; ph < NPHASE; ++ph) { a.ph_lo = ph; a.ph_hi = ph + 1; hipLaunchKernelGGL(fwd, dim3(grid), dim3(NWAVES * 64), LDS_BYTES, stream, a);
        const hipError_t le = hipPeekAtLastError(); if (le != hipSuccess) { fprintf(stderr, "kernel_launch: launch %d failed: %s\n", ph, hipGetErrorName(le)); break; } }
#else
    a.ph_lo = 0; a.ph_hi = NPHASE;
    void* kargs[] = {&a};
    const hipError_t le = hipLaunchCooperativeKernel((const void*)fwd, dim3(grid), dim3(NWAVES * 64), kargs, LDS_BYTES, stream);
    if (le != hipSuccess) fprintf(stderr, "kernel_launch: cooperative launch failed: %s (grid %d)\n", hipGetErrorName(le), grid);
#endif
}
```
